# Optimizing an MI355X kernel written in HIP

```python
import jax
import jax.numpy as jnp
from jax import lax
import numpy as np

D_MODEL = 1024
BATCH = 8
SEQ = 2048
DEPTH = 4

HEAD_DIM = 64
ROT_DIM = HEAD_DIM // 4
ROPE_THETA = 500000.0
BLOCK_Q = 128
NORM_EPS = 1e-6
N_EVEN = (DEPTH + 1) // 2
N_ODD = DEPTH // 2

A_HEADS = 8
A_KV_HEADS = 2
IDX_HEADS = 8
IDX_DIM = 32
IDX_ROT = IDX_DIM // 4
TOPK_MAX = 256

B_HEADS = 8
DILATED_PATTERNS = ((128, 1), (512, 4), (2048, 16))

EVEN_SPLITS = (A_HEADS * HEAD_DIM, A_KV_HEADS * HEAD_DIM, A_KV_HEADS * HEAD_DIM,
               IDX_HEADS * IDX_DIM, IDX_DIM, IDX_HEADS,
               B_HEADS * HEAD_DIM, B_HEADS * HEAD_DIM, B_HEADS * HEAD_DIM)
EVEN_IN = sum(EVEN_SPLITS)
EVEN_MIX = (A_HEADS + B_HEADS) * HEAD_DIM

C_HEADS = 8
C_NOPE = 64
C_ROPE = 32
C_V = 64
Q_LORA = 256
KV_LORA = 128

D_RNN = 512
RG_BLOCKS = 8
RG_BW = D_RNN // RG_BLOCKS
CONV_W = 4
RG_C = 8.0

ODD_SPLITS = (Q_LORA, KV_LORA, C_ROPE, D_RNN, D_RNN)
ODD_IN = sum(ODD_SPLITS)
ODD_MIX = C_HEADS * C_V + D_RNN

D_FF = 3584
N_EXPERTS = 8
TOP_K = 2
D_FF_EXPERT = 3584
MOE_BLOCK = 128

kernel_name = 'hybrid_dsa_dilated_mla_rglru_moe'


def rms_norm(x, g):
    xf = x.astype(jnp.float32)
    y = xf * lax.rsqrt(jnp.mean(xf * xf, axis=-1, keepdims=True) + NORM_EPS)
    return (y * g.astype(jnp.float32)).astype(x.dtype)


def apply_rope(x, rot_dim):
    s = x.shape[1]
    half = rot_dim // 2
    inv_freq = 1.0 / (ROPE_THETA ** (jnp.arange(half, dtype=jnp.float32) * (2.0 / rot_dim)))
    ang = jnp.arange(s, dtype=jnp.float32)[:, None] * inv_freq[None, :]
    bshape = (1, s) + (1,) * (x.ndim - 3) + (half,)
    cos = jnp.cos(ang).reshape(bshape)
    sin = jnp.sin(ang).reshape(bshape)
    x1 = x[..., :half].astype(jnp.float32)
    x2 = x[..., half:rot_dim].astype(jnp.float32)
    rot = jnp.concatenate([x1 * cos - x2 * sin, x1 * sin + x2 * cos], axis=-1).astype(x.dtype)
    return jnp.concatenate([rot, x[..., rot_dim:]], axis=-1)


def split_cols(a, sizes):
    return jnp.split(a, [int(c) for c in np.cumsum(sizes)[:-1]], axis=-1)


def swiglu(x, w_gate, w_up, w_down):
    return (jax.nn.silu(x @ w_gate) * (x @ w_up)) @ w_down


def over_query_blocks(fn, b, s):
    out = lax.map(fn, jnp.arange(s // BLOCK_Q))
    return jnp.swapaxes(out, 0, 1).reshape(b, s, out.shape[-1])


def dsa_attention(q, k, v, qi, ki, wi):
    b, s = q.shape[:2]
    topk = min(TOPK_MAX, s // 4)
    group = A_HEADS // A_KV_HEADS
    scale = HEAD_DIM ** -0.5
    gather = jax.vmap(lambda arr, idx: arr[idx])
    key_pos = jnp.arange(s)
    ki32 = ki.astype(jnp.float32)

    def block(i):
        t0 = i * BLOCK_Q
        qpos = t0 + jnp.arange(BLOCK_Q)
        qb = lax.dynamic_slice_in_dim(q, t0, BLOCK_Q, axis=1)
        qib = lax.dynamic_slice_in_dim(qi, t0, BLOCK_Q, axis=1).astype(jnp.float32)
        wib = lax.dynamic_slice_in_dim(wi, t0, BLOCK_Q, axis=1).astype(jnp.float32)
        logit = jnp.einsum('bqhd,bsd->bqhs', qib, ki32) * (IDX_DIM ** -0.5)
        score = jnp.einsum('bqh,bqhs->bqs', wib, jax.nn.relu(logit))
        causal = key_pos[None, :] <= qpos[:, None]
        score = jnp.where(causal[None], score, -jnp.inf)
        _, idx = lax.top_k(score, topk)
        valid = idx <= qpos[None, :, None]
        kg = gather(k, idx)
        vg = gather(v, idx)
        qg = qb.reshape(b, BLOCK_Q, A_KV_HEADS, group, HEAD_DIM)
        sc = jnp.einsum('bqngd,bqknd->bngqk', qg, kg).astype(jnp.float32) * scale
        sc = jnp.where(valid[:, None, None], sc, -jnp.inf)
        p = jax.nn.softmax(sc, axis=-1).astype(v.dtype)
        o = jnp.einsum('bngqk,bqknd->bqngd', p, vg)
        return o.reshape(b, BLOCK_Q, A_HEADS * HEAD_DIM)

    return over_query_blocks(block, b, s)


def dilated_attention(q, k, v):
    b, s, h, dh = q.shape
    scale = dh ** -0.5
    strided = []
    for (w, d) in DILATED_PATTERNS:
        pad = ((0, 0), (w, 0), (0, 0), (0, 0))
        kp = jnp.pad(k, pad).reshape(b, (s + w) // d, d, h, dh)
        vp = jnp.pad(v, pad).reshape(b, (s + w) // d, d, h, dh)
        strided.append((kp, vp))

    def block(i):
        t0 = i * BLOCK_Q
        qb = lax.dynamic_slice_in_dim(q, t0, BLOCK_Q, axis=1)
        outs, lses = [], []
        for (w, d), (kp, vp) in zip(DILATED_PATTERNS, strided):
            n_off = w // d
            nq = BLOCK_Q // d
            band = n_off + nq
            qs = qb.reshape(b, nq, d, h, dh)
            ks = lax.dynamic_slice_in_dim(kp, t0 // d, band, axis=1)
            vs = lax.dynamic_slice_in_dim(vp, t0 // d, band, axis=1)
            sc = jnp.einsum('bmchd,buchd->bhcmu', qs, ks).astype(jnp.float32) * scale
            m_idx = jnp.arange(nq)[:, None]
            u_idx = jnp.arange(band)[None, :]
            j = m_idx + n_off - u_idx
            key_pos = t0 + (u_idx - n_off) * d + jnp.arange(d)[:, None]
            mask = ((j >= 0) & (j <= n_off))[None] & (key_pos >= 0)[:, None, :]
            sc = jnp.where(mask[None, None], sc, -jnp.inf)
            lse = jax.nn.logsumexp(sc, axis=-1)
            p = jnp.exp(sc - lse[..., None]).astype(v.dtype)
            o = jnp.einsum('bhcmu,buchd->bmchd', p, vs).reshape(b, BLOCK_Q, h, dh)
            outs.append(o)
            lses.append(jnp.transpose(lse, (0, 3, 2, 1)).reshape(b, BLOCK_Q, h))
        wts = jax.nn.softmax(jnp.stack(lses, axis=-1), axis=-1).astype(v.dtype)
        o = jnp.einsum('bqhr,rbqhd->bqhd', wts, jnp.stack(outs, axis=0))
        return o.reshape(b, BLOCK_Q, h * dh)

    return over_query_blocks(block, b, s)


def mla_attention(c_q, c_kv, k_rope, q_norm, w_uq, kv_norm, w_ukv):
    b, s = c_q.shape[:2]
    q = (rms_norm(c_q, q_norm) @ w_uq).reshape(b, s, C_HEADS, C_NOPE + C_ROPE)
    q_nope, q_rope = q[..., :C_NOPE], apply_rope(q[..., C_NOPE:], C_ROPE)
    kv = (rms_norm(c_kv, kv_norm) @ w_ukv).reshape(b, s, C_HEADS, C_NOPE + C_V)
    k_nope, v = kv[..., :C_NOPE], kv[..., C_NOPE:]
    k_rope = apply_rope(k_rope, C_ROPE)
    scale = (C_NOPE + C_ROPE) ** -0.5
    key_pos = jnp.arange(s)

    def block(i):
        t0 = i * BLOCK_Q
        qpos = t0 + jnp.arange(BLOCK_Q)
        qn = lax.dynamic_slice_in_dim(q_nope, t0, BLOCK_Q, axis=1)
        qr = lax.dynamic_slice_in_dim(q_rope, t0, BLOCK_Q, axis=1)
        sc = (jnp.einsum('bqhd,bshd->bhqs', qn, k_nope)
              + jnp.einsum('bqhd,bsd->bhqs', qr, k_rope)).astype(jnp.float32) * scale
        causal = key_pos[None, :] <= qpos[:, None]
        sc = jnp.where(causal[None, None], sc, -jnp.inf)
        p = jax.nn.softmax(sc, axis=-1).astype(v.dtype)
        o = jnp.einsum('bhqs,bshd->bqhd', p, v)
        return o.reshape(b, BLOCK_Q, C_HEADS * C_V)

    return over_query_blocks(block, b, s)


def rglru_mixer(xr, gate, conv_w, conv_b, w_a, b_a, w_x, b_x, lam):
    b, s, _ = xr.shape
    xc = lax.conv_general_dilated(xr, conv_w[:, None, :], window_strides=(1,),
                                  padding=((CONV_W - 1, 0),),
                                  dimension_numbers=('NWC', 'WIO', 'NWC'),
                                  feature_group_count=D_RNN)
    xc = (xc + conv_b).astype(jnp.float32)
    xb = xc.reshape(b, s, RG_BLOCKS, RG_BW)
    r = jax.nn.sigmoid(jnp.einsum('bsni,nij->bsnj', xb, w_a.astype(jnp.float32)).reshape(b, s, D_RNN)
                       + b_a.astype(jnp.float32))
    i_g = jax.nn.sigmoid(jnp.einsum('bsni,nij->bsnj', xb, w_x.astype(jnp.float32)).reshape(b, s, D_RNN)
                         + b_x.astype(jnp.float32))
    log_a = -RG_C * jax.nn.softplus(-lam.astype(jnp.float32)) * r
    a = jnp.exp(log_a)
    u = jnp.sqrt(-jnp.expm1(2.0 * log_a)) * (i_g * xc)

    def combine(left, right):
        a_l, b_l = left
        a_r, b_r = right
        return a_l * a_r, a_r * b_l + b_r

    _, h = lax.associative_scan(combine, (a, u), axis=1)
    return (h * jax.nn.gelu(gate.astype(jnp.float32))).astype(xr.dtype)


def moe_swiglu(x, router, w_gate, w_up, w_down):
    b, s, dm = x.shape
    n = b * s
    xf = x.reshape(n, dm)
    logits = (xf @ router).astype(jnp.float32)
    top_val, top_idx = lax.top_k(logits, TOP_K)
    gates = jax.nn.softmax(top_val, axis=-1)
    e_flat = top_idx.reshape(-1)
    g_flat = gates.reshape(-1)
    tok_flat = jnp.repeat(jnp.arange(n, dtype=jnp.int32), TOP_K)
    counts = jnp.bincount(e_flat, length=N_EXPERTS)
    padded = (counts + MOE_BLOCK - 1) // MOE_BLOCK * MOE_BLOCK
    pad_end = jnp.cumsum(padded)
    pad_start = pad_end - padded
    cnt_start = jnp.cumsum(counts) - counts
    order = jnp.argsort(e_flat)
    e_sorted = e_flat[order]
    rank = jnp.arange(n * TOP_K) - cnt_start[e_sorted]
    dest = pad_start[e_sorted] + rank
    n_rows = n * TOP_K + N_EXPERTS * MOE_BLOCK
    row_tok = jnp.full((n_rows,), n, jnp.int32).at[dest].set(tok_flat[order])
    row_gate = jnp.zeros((n_rows,), jnp.float32).at[dest].set(g_flat[order])
    n_blk = n_rows // MOE_BLOCK
    blk_expert = jnp.clip(jnp.searchsorted(pad_end, jnp.arange(n_blk) * MOE_BLOCK, side='right'),
                          0, N_EXPERTS - 1)
    x_rows = jnp.concatenate([xf, jnp.zeros((1, dm), xf.dtype)], axis=0)[row_tok]
    x_rows = x_rows.reshape(n_blk, MOE_BLOCK, dm)

    def expert_block(args):
        xb, e = args
        return swiglu(xb, w_gate[e], w_up[e], w_down[e])

    y_rows = lax.map(expert_block, (x_rows, blk_expert)).reshape(n_rows, dm)
    y_rows = y_rows * row_gate[:, None].astype(y_rows.dtype)
    y = jax.ops.segment_sum(y_rows, row_tok, num_segments=n + 1)[:n]
    return y.reshape(b, s, dm)


def setup_inputs(seed: int = 0) -> dict:
    key = jax.random.key(seed)
    ks = iter(jax.random.split(key, 40))
    res = (2.0 * DEPTH) ** -0.5

    def nrm(shape, fan_in, extra=1.0):
        return jax.random.normal(next(ks), shape, jnp.float32) * (extra * fan_in ** -0.5)

    def gain(shape):
        return 1.0 + 0.05 * jax.random.normal(next(ks), shape, jnp.float32)

    def bias(shape):
        return 0.01 * jax.random.normal(next(ks), shape, jnp.float32)

    x = jax.random.normal(next(ks), (BATCH, SEQ, D_MODEL), jnp.float32)
    u = jax.random.uniform(next(ks), (N_ODD, D_RNN), jnp.float32, minval=0.9, maxval=0.999)
    a0 = u ** (1.0 / RG_C)
    rg_lambda = jnp.log(a0) - jnp.log1p(-a0)
    return {
        'x': x,
        'ev_norm_mix': gain((N_EVEN, D_MODEL)),
        'ev_w_in': nrm((N_EVEN, D_MODEL, EVEN_IN), D_MODEL),
        'ev_w_out': nrm((N_EVEN, EVEN_MIX, D_MODEL), EVEN_MIX, res),
        'ev_norm_ffn': gain((N_EVEN, D_MODEL)),
        'ffn_w_gate': nrm((N_EVEN, D_MODEL, D_FF), D_MODEL),
        'ffn_w_up': nrm((N_EVEN, D_MODEL, D_FF), D_MODEL),
        'ffn_w_down': nrm((N_EVEN, D_FF, D_MODEL), D_FF, res),
        'od_norm_mix': gain((N_ODD, D_MODEL)),
        'od_w_in': nrm((N_ODD, D_MODEL, ODD_IN), D_MODEL),
        'mla_q_norm': gain((N_ODD, Q_LORA)),
        'mla_w_uq': nrm((N_ODD, Q_LORA, C_HEADS * (C_NOPE + C_ROPE)), Q_LORA),
        'mla_kv_norm': gain((N_ODD, KV_LORA)),
        'mla_w_ukv': nrm((N_ODD, KV_LORA, C_HEADS * (C_NOPE + C_V)), KV_LORA),
        'rg_conv_w': nrm((N_ODD, CONV_W, D_RNN), CONV_W),
        'rg_conv_b': bias((N_ODD, D_RNN)),
        'rg_w_a': nrm((N_ODD, RG_BLOCKS, RG_BW, RG_BW), RG_BW),
        'rg_b_a': bias((N_ODD, D_RNN)),
        'rg_w_x': nrm((N_ODD, RG_BLOCKS, RG_BW, RG_BW), RG_BW),
        'rg_b_x': bias((N_ODD, D_RNN)),
        'rg_lambda': rg_lambda,
        'od_w_out': nrm((N_ODD, ODD_MIX, D_MODEL), ODD_MIX, res),
        'od_norm_ffn': gain((N_ODD, D_MODEL)),
        'moe_router': nrm((N_ODD, D_MODEL, N_EXPERTS), D_MODEL),
        'moe_w_gate': nrm((N_ODD, N_EXPERTS, D_MODEL, D_FF_EXPERT), D_MODEL),
        'moe_w_up': nrm((N_ODD, N_EXPERTS, D_MODEL, D_FF_EXPERT), D_MODEL),
        'moe_w_down': nrm((N_ODD, N_EXPERTS, D_FF_EXPERT, D_MODEL), D_FF_EXPERT, res),
        'final_norm': gain((D_MODEL,)),
    }


def reference(x, ev_norm_mix, ev_w_in, ev_w_out, ev_norm_ffn, ffn_w_gate, ffn_w_up, ffn_w_down,
              od_norm_mix, od_w_in, mla_q_norm, mla_w_uq, mla_kv_norm, mla_w_ukv,
              rg_conv_w, rg_conv_b, rg_w_a, rg_b_a, rg_w_x, rg_b_x, rg_lambda,
              od_w_out, od_norm_ffn, moe_router, moe_w_gate, moe_w_up, moe_w_down, final_norm):
    b, s, _ = x.shape
    for layer in range(DEPTH):
        i = layer // 2
        if layer % 2 == 0:
            h = rms_norm(x, ev_norm_mix[i])
            qa, ka, va, qi, ki, wi, qb, kb, vb = split_cols(h @ ev_w_in[i], EVEN_SPLITS)
            qa = apply_rope(qa.reshape(b, s, A_HEADS, HEAD_DIM), ROT_DIM)
            ka = apply_rope(ka.reshape(b, s, A_KV_HEADS, HEAD_DIM), ROT_DIM)
            va = va.reshape(b, s, A_KV_HEADS, HEAD_DIM)
            qi = apply_rope(qi.reshape(b, s, IDX_HEADS, IDX_DIM), IDX_ROT)
            ki = apply_rope(ki, IDX_ROT)
            wi = wi * (IDX_HEADS ** -0.5)
            out_a = dsa_attention(qa, ka, va, qi, ki, wi)
            qb = apply_rope(qb.reshape(b, s, B_HEADS, HEAD_DIM), ROT_DIM)
            kb = apply_rope(kb.reshape(b, s, B_HEADS, HEAD_DIM), ROT_DIM)
            vb = vb.reshape(b, s, B_HEADS, HEAD_DIM)
            out_b = dilated_attention(qb, kb, vb)
            x = x + jnp.concatenate([out_a, out_b], axis=-1) @ ev_w_out[i]
            x = x + swiglu(rms_norm(x, ev_norm_ffn[i]), ffn_w_gate[i], ffn_w_up[i], ffn_w_down[i])
        else:
            h = rms_norm(x, od_norm_mix[i])
            c_q, c_kv, k_rope, x_rnn, g_rnn = split_cols(h @ od_w_in[i], ODD_SPLITS)
            out_c = mla_attention(c_q, c_kv, k_rope, mla_q_norm[i], mla_w_uq[i],
                                  mla_kv_norm[i], mla_w_ukv[i])
            out_d = rglru_mixer(x_rnn, g_rnn, rg_conv_w[i], rg_conv_b[i], rg_w_a[i], rg_b_a[i],
                                rg_w_x[i], rg_b_x[i], rg_lambda[i])
            x = x + jnp.concatenate([out_c, out_d], axis=-1) @ od_w_out[i]
            x = x + moe_swiglu(rms_norm(x, od_norm_ffn[i]), moe_router[i], moe_w_gate[i],
                               moe_w_up[i], moe_w_down[i])
    return rms_norm(x, final_norm)
```

```cpp
#include <hip/hip_runtime.h>
#include <cstdio>
#include <cstdint>
#include <cmath>

#ifndef MK_MULTI
#define MK_MULTI 1
#endif

#define DI __device__ __forceinline__
#define LAS __attribute__((address_space(3)))
#define GAS __attribute__((address_space(1)))
typedef unsigned short bf16_t;
typedef short bf16x8 __attribute__((ext_vector_type(8)));
typedef short s16x4 __attribute__((ext_vector_type(4)));
typedef float f32x2 __attribute__((ext_vector_type(2)));
typedef float f32x4 __attribute__((ext_vector_type(4)));
typedef float f32x16 __attribute__((ext_vector_type(16)));
typedef unsigned u32x2 __attribute__((ext_vector_type(2)));
typedef unsigned u32x4 __attribute__((ext_vector_type(4)));
typedef __bf16 bf16x2_t __attribute__((ext_vector_type(2)));

constexpr int SEQ = 2048, BATCH = 8, DM = 1024, MTOK = BATCH * SEQ;
constexpr int EV_N = 2600, EV_NP = 2816;
constexpr int OD_N = 1440, OD_NP = 1536;
constexpr int DFF = 3584;
constexpr int NEXP = 8;
constexpr int MOE_ROWS = 2 * MTOK + NEXP * 256;
constexpr int C_QA = 0, C_KA = 512, C_VA = 640, C_QB = 768, C_KB = 1280, C_VB = 1792, C_QI = 2304, C_KI = 2560, C_WI = 2592;
constexpr int C_CQ = 0, C_CKV = 256, C_KR = 384, C_XR = 512, C_GR = 1024;

constexpr size_t MiB = 1u << 20;
constexpr size_t WS_CTL = 0, CTL_ZERO_BYTES = 1 * MiB;
constexpr size_t WS_ROPE = 1 * MiB;
constexpr size_t WS_WE = 2 * MiB;
constexpr size_t WE_IN = 0, WE_OUT = 6 * MiB, WE_GU = 8 * MiB, WE_DN = 23 * MiB;
constexpr size_t WS_WO = 34 * MiB;
constexpr size_t WO_IN = 0, WO_UQ = 3 * MiB, WO_UKV = 4 * MiB, WO_OUT = 5 * MiB, WO_RG = 7 * MiB, WO_MGU = 8 * MiB, WO_MDN = 120 * MiB;
constexpr size_t WS_X = 218 * MiB;
constexpr size_t WS_H = 282 * MiB;
constexpr size_t WS_MIX = 314 * MiB;
constexpr size_t WS_PY = 346 * MiB;
constexpr size_t PY_P2 = 0, PY_CQN = 48 * MiB, PY_CKVN = 56 * MiB, PY_Q2 = 64 * MiB, PY_KV2 = 88 * MiB;
constexpr size_t PY_XR = 0, PY_Y = 68 * MiB;
constexpr size_t WS_BIG = 550 * MiB;
constexpr size_t BIG_DIL = 128 * MiB;
constexpr size_t WS_MISC = 788 * MiB;
constexpr size_t MISC_MASK = 0, MISC_AGG = 4 * MiB, MISC_RT = 6 * MiB;
constexpr size_t WS_END = 796 * MiB;

constexpr int CW_BAR = 4096;
constexpr int CW_CNT = 64;

constexpr int LDS_MISC_OFF = 143360;
constexpr int LDS_BYTES = 147456;

DI unsigned cvtpk(float lo, float hi) { f32x2 v = {lo, hi}; bf16x2_t b = __builtin_convertvector(v, bf16x2_t); return __builtin_bit_cast(unsigned, b); }
DI float bf2f(unsigned b) { return __uint_as_float(b << 16); }
DI float bflo(unsigned w) { return __uint_as_float(w << 16); }
DI float bfhi(unsigned w) { return __uint_as_float(w & 0xffff0000u); }
DI float wave_sum(float v) {
#pragma unroll
    for (int o = 1; o < 64; o <<= 1) v += __shfl_xor(v, o);
    return v;
}
DI int crow(int i, int hh) { return (i & 3) + 8 * (i >> 2) + 4 * hh; }
#define LDS_WAIT() asm volatile("s_waitcnt lgkmcnt(0)" ::: "memory")
#define VM_WAIT() asm volatile("s_waitcnt vmcnt(0)" ::: "memory")

namespace pg8 {
constexpr int BM = 256, BK = 64, HALF = 128, HTB = HALF * BK * 2, STAGE_BYTES = 8 * HTB, NXCD = 8, WGM = 8;
__host__ __device__ __forceinline__ int lds_byte(int r, int c) { const int st = (r >> 4) * 2 + (c >> 5), rr = r & 15, cc = c & 31, ob = rr * 64 + cc * 2; return st * 1024 + (ob ^ (((ob >> 9) & 1) << 5)); }
__host__ __device__ __forceinline__ void stage_rc(int b, int& R, int& C) { const int st = b / 1024, sb = b % 1024, swz = sb ^ (((sb >> 9) & 1) << 5); R = (st >> 1) * 16 + swz / 64; C = (st & 1) * 32 + (swz % 64) / 2; }
__host__ __device__ __forceinline__ int perm32(int rho) { const int n = rho >> 4, i = rho & 15; return 8 * (i >> 2) + 4 * n + (i & 3); }

struct Unit { int pm, pn, e; };
struct Gemm { const bf16_t* A; const bf16_t* Bt; int lda; int K; size_t estride; };

__device__ __forceinline__ int xcd_remap(int L, int nwg) { const int q = nwg / NXCD, r = nwg % NXCD, xcd = L % NXCD, off = L / NXCD; return (xcd < r ? xcd * (q + 1) : r * (q + 1) + (xcd - r) * q) + off; }

struct StaticOrder {
    int nM, nN, nwg, G, c;
    __device__ void init(int M, int N, int G_, int c_) { nM = M / BM; nN = N / BM; nwg = nM * nN; G = G_; c = c_; }
    __device__ bool next(int i, Unit& u) const {
        const long L = (long)i * G + c; if (L >= nwg) return false;
        const int wgid = xcd_remap((int)L, nwg);
        const int nig = WGM * nN, gid = wgid / nig, fm = gid * WGM, gsz = (nM - fm) < WGM ? (nM - fm) : WGM;
        u.pm = fm + ((wgid % nig) % gsz); u.pn = (wgid % nig) / gsz; u.e = 0; return true;
    }
};
struct MoeOrder {
    int nN, nwg, G, c; int ts[9];
    __device__ bool next(int i, Unit& u) const {
        const long L = (long)i * G + c; if (L >= nwg) return false;
        const int wgid = xcd_remap((int)L, nwg);
        const int nig = WGM * nN, gid = wgid / nig, fm = gid * WGM, nM = ts[8], gsz = (nM - fm) < WGM ? (nM - fm) : WGM;
        u.pm = fm + ((wgid % nig) % gsz); u.pn = (wgid % nig) / gsz;
        int e = 0;
#pragma unroll
        for (int j = 1; j < 8; ++j) e += (u.pm >= ts[j]) ? 1 : 0;
        u.e = e; return true;
    }
};

template <class Epi, class Sched, bool ALIGN_EPI>
__device__ __forceinline__ void gemm_phase(LAS unsigned char* lds, const Gemm g, const Sched& S, const Epi& E) {
    int tid = threadIdx.x; asm volatile("" : "+v"(tid));
    const int wid = __builtin_amdgcn_readfirstlane(tid >> 6), lane = tid & 63, wr = wid >> 2, wc = wid & 3, fr = lane & 15, fq = lane >> 4;
    int K = g.K, lda = g.lda; asm volatile("" : "+s"(K), "+s"(lda)); const int nt = K / BK;
    unsigned voffA[2], voffB[2];
#pragma unroll
    for (int i = 0; i < 2; ++i) { int R, C; stage_rc(tid * 16 + i * 8192, R, C); const int Rb = Epi::PERM ? ((R & ~31) + perm32(R & 31)) : R;
        voffA[i] = (unsigned)(R * lda + C) * 2u; voffB[i] = (unsigned)(Rb * K + C) * 2u; }
    const size_t kstep = (size_t)(BK * 2);
    const size_t hstepA = (size_t)HALF * lda * 2, hstepB = (size_t)HALF * K * 2;
    const size_t tstepA = 2 * hstepA, tstepB = 2 * hstepB;
    const unsigned ldsw = (unsigned)wid * 1024u;
    const int aoff = lds_byte(wr * 64 + fr, fq * 8), boff = lds_byte(wc * 32 + fr, fq * 8);
#define PG8_SA(b, h) (((b) * 2 + (h)) * HTB)
#define PG8_SB(b, h) ((4 + (b) * 2 + (h)) * HTB)
#define PG8_STAGE(bufoff, gbase, voff) do { _Pragma("unroll") for (int _i = 0; _i < 2; ++_i) \
        __builtin_amdgcn_global_load_lds((const unsigned*)((const char*)(gbase) + (voff)[_i]), (LAS unsigned*)(lds + (bufoff) + ldsw + _i * 8192), 16, 0, 0); } while (0)
#define PG8_LDA(dst, b, h) do { _Pragma("unroll") for (int m = 0; m < 4; ++m) _Pragma("unroll") for (int k = 0; k < 2; ++k) dst[m][k] = *(const LAS bf16x8*)(lds + PG8_SA(b, h) + aoff + m * 2048 + k * 1024); } while (0)
#define PG8_LDB(dst, b, h) do { _Pragma("unroll") for (int n = 0; n < 2; ++n) _Pragma("unroll") for (int k = 0; k < 2; ++k) dst[n][k] = *(const LAS bf16x8*)(lds + PG8_SB(b, h) + boff + n * 2048 + k * 1024); } while (0)
#define PG8_MMA(ai, bj, At, Bt) do { __builtin_amdgcn_s_setprio(1); _Pragma("unroll") for (int m = 0; m < 4; ++m) _Pragma("unroll") for (int n = 0; n < 2; ++n) _Pragma("unroll") for (int k = 0; k < 2; ++k) \
        acc[ai][bj][m][n] = __builtin_amdgcn_mfma_f32_16x16x32_bf16(Bt[n][k], At[m][k], acc[ai][bj][m][n], 0, 0, 0); __builtin_amdgcn_s_setprio(0); } while (0)
#define PG8_WAIT_V(n) asm volatile("s_waitcnt vmcnt(" #n ")" ::: "memory")
#define PG8_WAIT_L(n) asm volatile("s_waitcnt lgkmcnt(" #n ")" ::: "memory")
#define PG8_BAR __builtin_amdgcn_s_barrier()
#define PG8_SCHED __builtin_amdgcn_sched_barrier(0)
    Unit cur, nxt; int ui = 0;
    if (!S.next(0, cur)) return;
    f32x4 acc[2][2][4][2];
#pragma unroll
    for (int a = 0; a < 2; ++a)
#pragma unroll
        for (int b = 0; b < 2; ++b)
#pragma unroll
            for (int m = 0; m < 4; ++m)
#pragma unroll
                for (int n = 0; n < 2; ++n) acc[a][b][m][n] = (f32x4){0.f, 0.f, 0.f, 0.f};
    bf16x8 At[4][2], B0[2][2], B1[2][2];
    const char* cA = (const char*)g.A + (size_t)cur.pm * tstepA; const char* cB = (const char*)g.Bt + (size_t)cur.e * g.estride * 2 + (size_t)cur.pn * tstepB;
    PG8_STAGE(PG8_SB(0, 0), cB, voffB); PG8_STAGE(PG8_SB(0, 1), cB + hstepB, voffB); PG8_STAGE(PG8_SA(0, 0), cA, voffA); PG8_STAGE(PG8_SA(0, 1), cA + hstepA, voffA);
    if (wr == 1) PG8_BAR;
    PG8_WAIT_V(2); PG8_BAR;
    PG8_STAGE(PG8_SB(1, 0), cB + kstep, voffB); PG8_STAGE(PG8_SA(1, 0), cA + kstep, voffA); PG8_STAGE(PG8_SB(1, 1), cB + hstepB + kstep, voffB);
    PG8_WAIT_V(6); PG8_BAR;
    for (;;) {
        const bool has_next = S.next(ui + 1, nxt);
        const char* nA = has_next ? (const char*)g.A + (size_t)nxt.pm * tstepA : cA; const char* nB = has_next ? (const char*)g.Bt + (size_t)nxt.e * g.estride * 2 + (size_t)nxt.pn * tstepB : cB;
        for (int t = 0; t < nt; t += 2) {
            const bool last = (t == nt - 2);
            const char* a1 = cA + (size_t)(t + 1) * kstep;
            const char* a2 = last ? nA : cA + (size_t)(t + 2) * kstep; const char* b2 = last ? nB : cB + (size_t)(t + 2) * kstep;
            const char* a3 = a2 + kstep; const char* b3 = b2 + kstep;
            PG8_LDB(B0, 0, 0); PG8_LDB(B1, 0, 1); PG8_SCHED; PG8_LDA(At, 0, 0); PG8_STAGE(PG8_SA(1, 1), a1 + hstepA, voffA);
            PG8_WAIT_V(8); PG8_WAIT_L(0); PG8_BAR; PG8_MMA(0, 0, At, B0); PG8_MMA(0, 1, At, B1); PG8_BAR; PG8_SCHED;
            PG8_LDA(At, 0, 1); PG8_STAGE(PG8_SB(0, 0), b2, voffB); PG8_STAGE(PG8_SB(0, 1), b2 + hstepB, voffB); PG8_STAGE(PG8_SA(0, 0), a2, voffA);
            PG8_WAIT_V(8); PG8_WAIT_L(0); PG8_BAR; PG8_MMA(1, 0, At, B0); PG8_MMA(1, 1, At, B1); PG8_BAR; PG8_SCHED;
            PG8_LDB(B0, 1, 0); PG8_LDB(B1, 1, 1); PG8_SCHED; PG8_LDA(At, 1, 0); PG8_STAGE(PG8_SA(0, 1), a2 + hstepA, voffA);
            PG8_WAIT_V(8); PG8_WAIT_L(0); PG8_BAR; PG8_MMA(0, 0, At, B0); PG8_MMA(0, 1, At, B1); PG8_BAR; PG8_SCHED;
            PG8_LDA(At, 1, 1); PG8_STAGE(PG8_SB(1, 0), b3, voffB); PG8_STAGE(PG8_SB(1, 1), b3 + hstepB, voffB); PG8_STAGE(PG8_SA(1, 0), a3, voffA);
            PG8_WAIT_V(8); PG8_WAIT_L(0); PG8_BAR; PG8_MMA(1, 0, At, B0); PG8_MMA(1, 1, At, B1); PG8_BAR; PG8_SCHED;
        }
        if constexpr (ALIGN_EPI) { if (wr == 0) PG8_BAR; }
        E(acc, cur, wr, wc, fr, fq);
        if (!has_next) break;
#pragma unroll
        for (int a = 0; a < 2; ++a)
#pragma unroll
            for (int b = 0; b < 2; ++b)
#pragma unroll
                for (int m = 0; m < 4; ++m)
#pragma unroll
                    for (int n = 0; n < 2; ++n) acc[a][b][m][n] = (f32x4){0.f, 0.f, 0.f, 0.f};
        cur = nxt; cA = nA; cB = nB; ++ui;
        if constexpr (ALIGN_EPI) { if (wr == 1) PG8_BAR; }
    }
    PG8_WAIT_V(0);
    if constexpr (!ALIGN_EPI) { if (wr == 0) PG8_BAR; }
    PG8_BAR;
#undef PG8_SA
#undef PG8_SB
#undef PG8_STAGE
#undef PG8_LDA
#undef PG8_LDB
#undef PG8_MMA
#undef PG8_WAIT_V
#undef PG8_WAIT_L
#undef PG8_BAR
#undef PG8_SCHED
}

template <int MODE> struct EpiBf16 {
    static constexpr bool PERM = true;
    bf16_t* O; int ldc; const float* rope;
    __device__ __forceinline__ void operator()(const f32x4 (&acc)[2][2][4][2], const Unit& u, int wr, int wc, int fr, int fq) const {
        const int row0 = u.pm * BM + wr * 64 + fr;
        const float* t16 = rope; const float* t8 = rope + 2048 * 16; const float* t32 = rope + 2048 * 24;
#pragma unroll
        for (int bj = 0; bj < 2; ++bj) {
            const int gc = u.pn * BM + bj * HALF + wc * 32 + 8 * fq;
            const float* tb = nullptr; int tstride = 0, sinoff = 0;
            if (MODE == 1) {
                const bool r64 = (gc < C_VA) || (gc >= C_QB && gc < C_VB);
                if (r64 && (gc & 63) < 16) { tb = t16 + ((gc & 63) >> 3) * 4; tstride = 16; sinoff = 8; }
                else if (gc >= C_QI && gc < C_WI && (gc & 31) == 0) { tb = t8; tstride = 8; sinoff = 4; }
            } else if (MODE == 2) {
                if (gc >= C_KR && gc < C_KR + 32) { tb = t32 + ((gc - C_KR) >> 3) * 4; tstride = 32; sinoff = 16; }
            } else if (MODE == 3) {
                if (gc >= 512) { tb = t32 + ((gc & 31) >> 3) * 4; tstride = 32; sinoff = 16; }
            }
#pragma unroll
            for (int ai = 0; ai < 2; ++ai)
#pragma unroll
                for (int m = 0; m < 4; ++m) {
                    const int row = row0 + ai * HALF + m * 16;
                    f32x4 v0 = acc[ai][bj][m][0], v1 = acc[ai][bj][m][1];
                    if (MODE != 0) { if (tb) { const float* tp = tb + (size_t)(row & (SEQ - 1)) * tstride; const f32x4 c = *(const f32x4*)tp, s = *(const f32x4*)(tp + sinoff);
                        const f32x4 a = v0 * c - v1 * s, b = v0 * s + v1 * c; v0 = a; v1 = b; } }
                    u32x4 w; w.x = cvtpk(v0[0], v0[1]); w.y = cvtpk(v0[2], v0[3]); w.z = cvtpk(v1[0], v1[1]); w.w = cvtpk(v1[2], v1[3]);
                    *(u32x4*)(O + (size_t)row * ldc + gc) = w;
                }
        }
    }
};
struct EpiF32 {
    static constexpr bool PERM = false;
    float* C; const float* base; int ldc;
    __device__ __forceinline__ void operator()(const f32x4 (&acc)[2][2][4][2], const Unit& u, int wr, int wc, int fr, int fq) const {
        const int row0 = u.pm * BM + wr * 64 + fr, col0 = u.pn * BM + wc * 32 + 4 * fq;
#pragma unroll
        for (int ai = 0; ai < 2; ++ai)
#pragma unroll
            for (int m = 0; m < 4; ++m) { const size_t off = (size_t)(row0 + ai * HALF + m * 16) * ldc + col0;
#pragma unroll
                for (int bj = 0; bj < 2; ++bj)
#pragma unroll
                    for (int n = 0; n < 2; ++n) { f32x4 v = acc[ai][bj][m][n]; if (base) v += *(const f32x4*)(base + off + bj * HALF + n * 16); *(f32x4*)(C + off + bj * HALF + n * 16) = v; } }
    }
};
struct EpiSwiGLU {
    static constexpr bool PERM = true;
    bf16_t* O;
    __device__ __forceinline__ void operator()(const f32x4 (&acc)[2][2][4][2], const Unit& u, int wr, int wc, int fr, int fq) const {
        const int row0 = u.pm * BM + wr * 64 + fr, col0 = u.pn * HALF + wc * 32 + 8 * fq;
#pragma unroll
        for (int ai = 0; ai < 2; ++ai)
#pragma unroll
            for (int m = 0; m < 4; ++m) {
                float r[8];
#pragma unroll
                for (int n = 0; n < 2; ++n)
#pragma unroll
                    for (int j = 0; j < 4; ++j) { const float gv = acc[ai][0][m][n][j], uv = acc[ai][1][m][n][j]; r[n * 4 + j] = gv * __builtin_amdgcn_rcpf(1.0f + __expf(-gv)) * uv; }
                u32x4 w; w.x = cvtpk(r[0], r[1]); w.y = cvtpk(r[2], r[3]); w.z = cvtpk(r[4], r[5]); w.w = cvtpk(r[6], r[7]);
                *(u32x4*)(O + (size_t)(row0 + ai * HALF + m * 16) * DFF + col0) = w;
            }
    }
};
}

#define XB_TMO      128
#define XB_XCNT(j)  (256  + 64 * (j))
#define XB_XSUB(j)  (1280 + 64 * (j))
#define XB_XGEN(j)  (2304 + 64 * (j))
#define XB_TOP      3328
#define XB_TOPGEN   3392
#define XCD_BAR_WORDS 3456
#define XB_SPIN_CAP (1u << 22)
DI unsigned xb_ld(unsigned* p)              { return __hip_atomic_load(p, __ATOMIC_RELAXED, __HIP_MEMORY_SCOPE_AGENT); }
DI unsigned xb_add(unsigned* p, unsigned v) { return __hip_atomic_fetch_add(p, v, __ATOMIC_RELAXED, __HIP_MEMORY_SCOPE_AGENT); }
DI unsigned xb_xcc_id() { return (unsigned)__builtin_amdgcn_s_getreg((3 << 11) | 20) & 0xFu; }
#define XB_SPIN(cond, bar) do { unsigned _sp = 0; while (cond) { __builtin_amdgcn_s_sleep(1); \
    if ((++_sp & 255u) == 0u) { if (xb_ld(&(bar)[XB_TMO])) break; if (_sp > XB_SPIN_CAP) { atomicAdd(&(bar)[XB_TMO], 1u); break; } } } } while (0)
struct XcdBarrier { unsigned* bar; unsigned x; volatile LAS unsigned* st; };
DI XcdBarrier xcd_barrier_post(unsigned* bar, volatile LAS unsigned* st) {
    XcdBarrier b; b.bar = bar; b.x = xb_xcc_id(); b.st = st;
    if (threadIdx.x == 0) (void)xb_add(&bar[XB_XCNT(b.x)], 1u);
    return b;
}
DI void xcd_barrier_complete(unsigned* bar, unsigned x, unsigned& nloc, unsigned& nx) {
    const unsigned G = gridDim.x * gridDim.y * gridDim.z;
    unsigned sum, cnt, mine, sp = 0u;
    for (;;) {
        sum = 0u; cnt = 0u; mine = 0u;
#pragma unroll
        for (unsigned j = 0; j < 16; ++j) { const unsigned c = xb_ld(&bar[XB_XCNT(j)]); sum += c; cnt += (c > 0u) ? 1u : 0u; mine = (j == x) ? c : mine; }
        if (sum == G) break;
        __builtin_amdgcn_s_sleep(1);
        if ((++sp & 255u) == 0u) { if (xb_ld(&bar[XB_TMO])) break; if (sp > XB_SPIN_CAP) { atomicAdd(&bar[XB_TMO], 1u); break; } }
    }
    nloc = mine > 0u ? mine : 1u; nx = cnt > 0u ? cnt : 1u;
}
DI void xcd_barrier(const XcdBarrier& b) {
    asm volatile("s_waitcnt vmcnt(0)" ::: "memory");
    __syncthreads();
    if (threadIdx.x == 0) {
        unsigned* bar = b.bar;
        __builtin_amdgcn_s_waitcnt(0);
        unsigned nloc = b.st[0], nx = b.st[1];
        if (nloc == 0u) { xcd_barrier_complete(bar, b.x, nloc, nx); b.st[0] = nloc; b.st[1] = nx; }
        const unsigned old = xb_add(&bar[XB_XSUB(b.x)], 1u);
        const unsigned gen = old / nloc;
        if (old + 1u == (gen + 1u) * nloc) {
            __builtin_amdgcn_fence(__ATOMIC_RELEASE, "agent");
            asm volatile("s_waitcnt vmcnt(0)" ::: "memory");
            const unsigned og = xb_add(&bar[XB_TOP], 1u);
            const unsigned tg = og / nx;
            if (og + 1u == (tg + 1u) * nx) xb_add(&bar[XB_TOPGEN], 1u);
            else XB_SPIN(xb_ld(&bar[XB_TOPGEN]) == tg, bar);
            __builtin_amdgcn_fence(__ATOMIC_ACQUIRE, "agent");
            xb_add(&bar[XB_XGEN(b.x)], 1u);
            asm volatile("s_waitcnt vmcnt(0)" ::: "memory");
        } else {
            XB_SPIN(xb_ld(&bar[XB_XGEN(b.x)]) == gen, bar);
            __builtin_amdgcn_fence(__ATOMIC_ACQUIRE, "agent");
            asm volatile("s_waitcnt vmcnt(0)" ::: "memory");
        }
    }
    __syncthreads();
}

struct Args { const float* in[28]; float* out; unsigned char* ws; int ph_lo, ph_hi; };
struct Frame {
    LAS unsigned char* lds;
    unsigned char* ws;
    const float* const* in;
    int tid, lane, wave, vcu, G, gw, NGW;
};

DI int pd64(int d) { if (d < 16) { const int i = d & 7, part = d >> 3; return (i >> 2) * 8 + part * 4 + (i & 3); } return d; }
DI int pd32m(int d) { const int i = d & 15, part = d >> 4; return (i >> 2) * 8 + part * 4 + (i & 3); }
struct RmPlain { int off; DI int operator()(int n) const { return off + n; } };
struct RmEvenIn { DI int operator()(int n) const {
    if (n < 512) return C_QA + (n & ~63) + pd64(n & 63);
    if (n < 640) { const int m = n - 512; return C_KA + (m & ~63) + pd64(m & 63); }
    if (n < 768) return C_VA + (n - 640);
    if (n < 1024) return C_QI + (n - 768);
    if (n < 1056) return C_KI + (n - 1024);
    if (n < 1064) return C_WI + (n - 1056);
    if (n < 1576) { const int m = n - 1064; return C_QB + (m & ~63) + pd64(m & 63); }
    if (n < 2088) { const int m = n - 1576; return C_KB + (m & ~63) + pd64(m & 63); }
    return C_VB + (n - 2088); } };
struct RmGateUp { int which; DI int operator()(int n) const { return (n >> 7) * 256 + which * 128 + (n & 127); } };
struct RmOddIn { DI int operator()(int n) const {
    if (n < 256) return C_CQ + n;
    if (n < 384) return C_CKV + (n - 256);
    if (n < 416) return C_KR + pd32m(n - 384);
    if (n < 928) return C_XR + (n - 416);
    return C_GR + (n - 928); } };
struct RmUq { DI int operator()(int n) const { const int h = n / 96, d = n - h * 96; return d < 64 ? h * 64 + d : 512 + h * 32 + pd32m(d - 64); } };

template <class RM> DI void cvt_item(const float* W, int N, bf16_t* WT, int ldk, const RM rm, int kb, int nb, int lane) {
    const int kg = lane >> 3, n4 = lane & 7, k0 = kb * 64 + kg * 8, n = nb * 32 + n4 * 4;
    if (n >= N) return;
    f32x4 v[8];
#pragma unroll
    for (int i = 0; i < 8; ++i) v[i] = *(const f32x4*)(W + (size_t)(k0 + i) * N + n);
#pragma unroll
    for (int q = 0; q < 4; ++q) { u32x4 w; w.x = cvtpk(v[0][q], v[1][q]); w.y = cvtpk(v[2][q], v[3][q]); w.z = cvtpk(v[4][q], v[5][q]); w.w = cvtpk(v[6][q], v[7][q]);
        *(u32x4*)(WT + (size_t)rm(n + q) * ldk + k0) = w; }
}
#define CVT_RANGE(cnt, nbn, ...) if (r < (cnt)) { const int kb = r / (nbn), nb = r % (nbn); (void)kb; (void)nb; __VA_ARGS__; continue; } r -= (cnt);

DI void phase_cvt_even(Frame& F, int li) {
    bf16_t* we = (bf16_t*)(F.ws + WS_WE);
    const float* w_in = F.in[2] + (size_t)li * 1024 * EV_N; const float* w_out = F.in[3] + (size_t)li * 1024 * 1024;
    const float* w_g = F.in[5] + (size_t)li * 1024 * DFF; const float* w_u = F.in[6] + (size_t)li * 1024 * DFF; const float* w_d = F.in[7] + (size_t)li * DFF * 1024;
    bf16_t* d_in = we + WE_IN / 2; bf16_t* d_out = we + WE_OUT / 2; bf16_t* d_gu = we + WE_GU / 2; bf16_t* d_dn = we + WE_DN / 2;
    constexpr int I_IN = 16 * 82, I_OUT = 16 * 32, I_G = 16 * 112, I_D = 56 * 32, NIT = I_IN + I_OUT + 2 * I_G + I_D;
    for (int it = F.gw; it < NIT; it += F.NGW) {
        int r = it;
        CVT_RANGE(I_IN, 82, cvt_item(w_in, EV_N, d_in, 1024, RmEvenIn{}, kb, nb, F.lane))
        CVT_RANGE(I_OUT, 32, cvt_item(w_out, 1024, d_out, 1024, RmPlain{0}, kb, nb, F.lane))
        CVT_RANGE(I_G, 112, cvt_item(w_g, DFF, d_gu, 1024, RmGateUp{0}, kb, nb, F.lane))
        CVT_RANGE(I_G, 112, cvt_item(w_u, DFF, d_gu, 1024, RmGateUp{1}, kb, nb, F.lane))
        CVT_RANGE(I_D, 32, cvt_item(w_d, 1024, d_dn, DFF, RmPlain{0}, kb, nb, F.lane))
    }
    for (int i = F.gw * 64 + F.lane; i < (EV_NP - EV_N) * 1024 / 8; i += F.NGW * 64) *(u32x4*)(d_in + (size_t)EV_N * 1024 + (size_t)i * 8) = (u32x4){0u, 0u, 0u, 0u};
}
DI void phase_cvt_odd(Frame& F, int li) {
    bf16_t* wo = (bf16_t*)(F.ws + WS_WO);
    const float* w_in = F.in[9] + (size_t)li * 1024 * OD_N; const float* w_uq = F.in[11] + (size_t)li * 256 * 768; const float* w_ukv = F.in[13] + (size_t)li * 128 * 1024;
    const float* w_out = F.in[21] + (size_t)li * 1024 * 1024; const float* w_a = F.in[16] + (size_t)li * 8 * 4096; const float* w_x = F.in[18] + (size_t)li * 8 * 4096;
    const float* m_g = F.in[24] + (size_t)li * NEXP * 1024 * DFF; const float* m_u = F.in[25] + (size_t)li * NEXP * 1024 * DFF; const float* m_d = F.in[26] + (size_t)li * NEXP * DFF * 1024;
    bf16_t* d_in = wo + WO_IN / 2; bf16_t* d_uq = wo + WO_UQ / 2; bf16_t* d_ukv = wo + WO_UKV / 2; bf16_t* d_out = wo + WO_OUT / 2; bf16_t* d_rg = wo + WO_RG / 2;
    bf16_t* d_mgu = wo + WO_MGU / 2; bf16_t* d_mdn = wo + WO_MDN / 2;
    constexpr int I_IN = 16 * 45, I_UQ = 4 * 24, I_UKV = 2 * 32, I_OUT = 16 * 32, I_RG = 32, I_G = 16 * 112, I_D = 56 * 32;
    constexpr int NIT = I_IN + I_UQ + I_UKV + I_OUT + I_RG + NEXP * (2 * I_G + I_D);
    for (int it = F.gw; it < NIT; it += F.NGW) {
        int r = it;
        CVT_RANGE(I_IN, 45, cvt_item(w_in, OD_N, d_in, 1024, RmOddIn{}, kb, nb, F.lane))
        CVT_RANGE(I_UQ, 24, cvt_item(w_uq, 768, d_uq, 256, RmUq{}, kb, nb, F.lane))
        CVT_RANGE(I_UKV, 32, cvt_item(w_ukv, 1024, d_ukv, 256, RmPlain{0}, kb, nb, F.lane))
        CVT_RANGE(I_OUT, 32, cvt_item(w_out, 1024, d_out, 1024, RmPlain{0}, kb, nb, F.lane))
        if (r < I_RG) { const int mat = r >> 1, nb = r & 1; const float* src = (mat < 8 ? w_a + mat * 4096 : w_x + (mat - 8) * 4096); cvt_item(src, 64, d_rg + mat * 4096, 64, RmPlain{0}, 0, nb, F.lane); continue; } r -= I_RG;
        { const int e = r / (2 * I_G + I_D); int q = r - e * (2 * I_G + I_D);
          if (q < I_G) { cvt_item(m_g + (size_t)e * 1024 * DFF, DFF, d_mgu + (size_t)e * 7168 * 1024, 1024, RmGateUp{0}, q / 112, q % 112, F.lane); continue; } q -= I_G;
          if (q < I_G) { cvt_item(m_u + (size_t)e * 1024 * DFF, DFF, d_mgu + (size_t)e * 7168 * 1024, 1024, RmGateUp{1}, q / 112, q % 112, F.lane); continue; } q -= I_G;
          cvt_item(m_d + (size_t)e * DFF * 1024, 1024, d_mdn + (size_t)e * 1024 * DFF, DFF, RmPlain{0}, q / 32, q % 32, F.lane); }
    }
    for (int i = F.gw * 64 + F.lane; i < 96 * 1024 / 8; i += F.NGW * 64) *(u32x4*)(d_in + (size_t)416 * 1024 + (size_t)i * 8) = (u32x4){0u, 0u, 0u, 0u};
    for (int i = F.gw * 64 + F.lane; i < 1024 * 16; i += F.NGW * 64) *(u32x4*)(d_ukv + (size_t)(i >> 4) * 256 + 128 + (i & 15) * 8) = (u32x4){0u, 0u, 0u, 0u};
}
DI void phase_rope_tables(Frame& F) {
    float* t16 = (float*)(F.ws + WS_ROPE); float* t8 = t16 + 2048 * 16; float* t32 = t16 + 2048 * 24;
    const double lnth = 13.122363377404328;
    for (int i = F.gw * 64 + F.lane; i < 2048 * 28; i += F.NGW * 64) {
        const int pos = i / 28, j = i % 28; int rot, f; float* dst;
        if (j < 8) { rot = 16; f = j; dst = t16 + pos * 16 + f; } else if (j < 12) { rot = 8; f = j - 8; dst = t8 + pos * 8 + f; } else { rot = 32; f = j - 12; dst = t32 + pos * 32 + f; }
        const float invf = (float)exp(-(double)(2 * f) / (double)rot * lnth);
        const float ang = (float)pos * invf;
        dst[0] = (float)cos((double)ang); dst[rot / 2] = (float)sin((double)ang);
    }
}

template <int MODE> DI void phase_norm(Frame& F, const float* src, const float* gain, bf16_t* H, float* outf) {
    float* X = (float*)(F.ws + WS_X);
    const float* Y = (const float*)(F.ws + WS_PY + PY_Y);
    const int* dest = (const int*)(F.ws + WS_MISC + MISC_RT); const float* rgate = (const float*)(F.ws + WS_MISC + MISC_RT + 256 * 1024);
    f32x4 g[4];
#pragma unroll
    for (int j = 0; j < 4; ++j) g[j] = *(const f32x4*)(gain + 4 * (F.lane + 64 * j));
    for (int row = F.gw; row < MTOK; row += F.NGW) {
        f32x4 v[4]; float ss = 0.f;
        const float* xr = (MODE == 0 ? src : X) + (size_t)row * DM;
#pragma unroll
        for (int j = 0; j < 4; ++j) v[j] = *(const f32x4*)(xr + 4 * (F.lane + 64 * j));
        if (MODE != 0) {
            const int d0 = dest[row * 2], d1 = dest[row * 2 + 1]; const float g0 = rgate[row * 2], g1 = rgate[row * 2 + 1];
            const float* y0 = Y + (size_t)d0 * DM; const float* y1 = Y + (size_t)d1 * DM;
#pragma unroll
            for (int j = 0; j < 4; ++j) { const f32x4 a = *(const f32x4*)(y0 + 4 * (F.lane + 64 * j)), b = *(const f32x4*)(y1 + 4 * (F.lane + 64 * j)); v[j] = v[j] + (a * g0 + b * g1); }
            if (MODE == 1) {
#pragma unroll
                for (int j = 0; j < 4; ++j) *(f32x4*)(X + (size_t)row * DM + 4 * (F.lane + 64 * j)) = v[j];
            }
        }
#pragma unroll
        for (int j = 0; j < 4; ++j) ss += (v[j][0] * v[j][0] + v[j][1] * v[j][1]) + (v[j][2] * v[j][2] + v[j][3] * v[j][3]);
        const float rstd = 1.0f / sqrtf(wave_sum(ss) * (1.0f / DM) + 1e-6f);
#pragma unroll
        for (int j = 0; j < 4; ++j) { const f32x4 y = v[j] * rstd * g[j];
            if (MODE == 2) *(f32x4*)(outf + (size_t)row * DM + 4 * (F.lane + 64 * j)) = y;
            else { u32x2 w; w.x = cvtpk(y[0], y[1]); w.y = cvtpk(y[2], y[3]); *(u32x2*)(H + (size_t)row * DM + 4 * (F.lane + 64 * j)) = w; } }
    }
}
DI void phase_norm_route(Frame& F, int li, const float* gain, bf16_t* H) {
    const float* X = (const float*)(F.ws + WS_X);
    const float* R = F.in[23] + (size_t)li * 1024 * 8;
    int* r_e = (int*)(F.ws + WS_MISC + MISC_RT + 512 * 1024); int* r_rank = r_e + 2 * MTOK; float* rgate = (float*)(F.ws + WS_MISC + MISC_RT + 256 * 1024);
    unsigned* cnt = (unsigned*)(F.ws + WS_CTL) + CW_CNT + 64 * li;
    LAS int* l_e = (LAS int*)F.lds; LAS int* l_rank = l_e + 128; LAS int* l_base = l_e + 256;
    f32x4 g[4]; f32x4 rt[4][4][2];
#pragma unroll
    for (int j = 0; j < 4; ++j) { g[j] = *(const f32x4*)(gain + 4 * (F.lane + 64 * j));
#pragma unroll
        for (int q = 0; q < 4; ++q) { const float* rp = R + (size_t)(4 * (F.lane + 64 * j) + q) * 8; rt[j][q][0] = *(const f32x4*)rp; rt[j][q][1] = *(const f32x4*)(rp + 4); } }
    for (int blk = F.vcu; blk < MTOK / 64; blk += F.G) {
        for (int i = 0; i < 8; ++i) {
            const int lr = F.wave * 8 + i, row = blk * 64 + lr;
            f32x4 v[4]; float ss = 0.f;
#pragma unroll
            for (int j = 0; j < 4; ++j) { v[j] = *(const f32x4*)(X + (size_t)row * DM + 4 * (F.lane + 64 * j)); ss += (v[j][0] * v[j][0] + v[j][1] * v[j][1]) + (v[j][2] * v[j][2] + v[j][3] * v[j][3]); }
            const float rstd = 1.0f / sqrtf(wave_sum(ss) * (1.0f / DM) + 1e-6f);
            f32x4 la = {0.f, 0.f, 0.f, 0.f}, lb = {0.f, 0.f, 0.f, 0.f};
#pragma unroll
            for (int j = 0; j < 4; ++j) { const f32x4 y = v[j] * rstd * g[j];
                u32x2 w; w.x = cvtpk(y[0], y[1]); w.y = cvtpk(y[2], y[3]); *(u32x2*)(H + (size_t)row * DM + 4 * (F.lane + 64 * j)) = w;
#pragma unroll
                for (int q = 0; q < 4; ++q) { la += rt[j][q][0] * y[q]; lb += rt[j][q][1] * y[q]; } }
            float lg[8];
#pragma unroll
            for (int e = 0; e < 4; ++e) { lg[e] = wave_sum(la[e]); lg[4 + e] = wave_sum(lb[e]); }
            int e0 = 0; float v0 = lg[0];
#pragma unroll
            for (int e = 1; e < 8; ++e) if (lg[e] > v0) { v0 = lg[e]; e0 = e; }
            int e1 = (e0 == 0) ? 1 : 0; float v1 = lg[e1];
#pragma unroll
            for (int e = 1; e < 8; ++e) if (e != e0 && lg[e] > v1) { v1 = lg[e]; e1 = e; }
            const float g1 = 1.0f / (1.0f + __expf(v0 - v1)), g0 = 1.0f - g1;
            if (F.lane == 0) { l_e[lr * 2] = e0; l_e[lr * 2 + 1] = e1; rgate[row * 2] = g0; rgate[row * 2 + 1] = g1; }
        }
        __syncthreads();
        if (F.tid < 8) { int n = 0; for (int idx = 0; idx < 128; ++idx) if (l_e[idx] == F.tid) l_rank[idx] = n++; l_base[F.tid] = (int)atomicAdd(&cnt[F.tid], (unsigned)n); }
        __syncthreads();
        if (F.tid < 128) { const int e = l_e[F.tid]; r_e[blk * 128 + F.tid] = e; r_rank[blk * 128 + F.tid] = l_base[e] + l_rank[F.tid]; }
        __syncthreads();
    }
}
DI void moe_tiles(Frame& F, int li, int (&ts)[9]) {
    unsigned* cnt = (unsigned*)(F.ws + WS_CTL) + CW_CNT + 64 * li; int acc = 0;
#pragma unroll
    for (int e = 0; e < 8; ++e) { ts[e] = acc; acc += ((int)__hip_atomic_load(&cnt[e], __ATOMIC_RELAXED, __HIP_MEMORY_SCOPE_AGENT) + 255) >> 8; }
    ts[8] = acc;
}
DI void phase_moe_scatter(Frame& F, int li, const bf16_t* H) {
    int ts[9]; moe_tiles(F, li, ts);
    const int* r_e = (const int*)(F.ws + WS_MISC + MISC_RT + 512 * 1024); const int* r_rank = r_e + 2 * MTOK; int* dest = (int*)(F.ws + WS_MISC + MISC_RT);
    bf16_t* XR = (bf16_t*)(F.ws + WS_PY + PY_XR);
    for (int row = F.gw; row < MTOK; row += F.NGW) {
        const u32x4 a = *(const u32x4*)(H + (size_t)row * DM + 8 * F.lane), b = *(const u32x4*)(H + (size_t)row * DM + 512 + 8 * F.lane);
#pragma unroll
        for (int k = 0; k < 2; ++k) { const int e = r_e[row * 2 + k]; int st = 0;
#pragma unroll
            for (int j = 0; j < 8; ++j) st = (e == j) ? ts[j] : st;
            const int d = st * 256 + r_rank[row * 2 + k];
            if (F.lane == 0) dest[row * 2 + k] = d;
            *(u32x4*)(XR + (size_t)d * DM + 8 * F.lane) = a; *(u32x4*)(XR + (size_t)d * DM + 512 + 8 * F.lane) = b; }
    }
}

typedef short v4i16_t __attribute__((ext_vector_type(4)));
constexpr int VT_STRIDE = 192, VT_BYTES = 32 * VT_STRIDE;
template <int NKS, class KL, class VL, class MK>
DI void wave_attn(const bf16x8 (&qf)[NKS], int kt_lo, int kt_hi, const KL kl, const VL vl, const MK mk, float c, LAS unsigned char* vt, int lane, f32x16 (&o)[2], float& m, float& l) {
    const int hh = lane >> 5;
    bf16x8 kn[NKS]; u32x4 vn[4];
    kl(kt_lo, kn); vl(kt_lo, vn);
    LAS unsigned char* vw = vt + (lane >> 3) * VT_STRIDE + (lane & 7) * 16;
    const LAS unsigned char* vr = vt + (4 * hh + ((lane & 15) >> 2)) * VT_STRIDE + ((lane >> 4) & 1) * 32 + (lane & 3) * 8;
    for (int kt = kt_lo; kt < kt_hi; ++kt) {
        bf16x8 kf[NKS]; u32x4 vc[4];
#pragma unroll
        for (int i = 0; i < NKS; ++i) kf[i] = kn[i];
#pragma unroll
        for (int i = 0; i < 4; ++i) vc[i] = vn[i];
        if (kt + 1 < kt_hi) { kl(kt + 1, kn); vl(kt + 1, vn); }
#pragma unroll
        for (int i = 0; i < 4; ++i) *(LAS u32x4*)(vw + i * 8 * VT_STRIDE) = vc[i];
        f32x16 s;
#pragma unroll
        for (int i = 0; i < 16; ++i) s[i] = 0.f;
#pragma unroll
        for (int ks = 0; ks < NKS; ++ks) s = __builtin_amdgcn_mfma_f32_32x32x16_bf16(kf[ks], qf[ks], s, 0, 0, 0);
        mk(kt, s);
        float mx = s[0];
#pragma unroll
        for (int i = 1; i < 16; ++i) mx = fmaxf(mx, s[i]);
        mx = fmaxf(mx, __shfl_xor(mx, 32));
        const float mnew = fmaxf(m, mx);
        const float msafe = (mnew == -INFINITY) ? 0.f : mnew;
        const float alpha = __builtin_amdgcn_exp2f((m - msafe) * c);
        float ps = 0.f;
#pragma unroll
        for (int i = 0; i < 16; ++i) { s[i] = __builtin_amdgcn_exp2f((s[i] - msafe) * c); ps += s[i]; }
        l = l * alpha + ps; m = mnew;
#pragma unroll
        for (int i = 0; i < 16; ++i) { o[0][i] *= alpha; o[1][i] *= alpha; }
        bf16x8 pf[2];
#pragma unroll
        for (int s2 = 0; s2 < 2; ++s2) { u32x4 w; w.x = cvtpk(s[8 * s2], s[8 * s2 + 1]); w.y = cvtpk(s[8 * s2 + 2], s[8 * s2 + 3]); w.z = cvtpk(s[8 * s2 + 4], s[8 * s2 + 5]); w.w = cvtpk(s[8 * s2 + 6], s[8 * s2 + 7]); pf[s2] = __builtin_bit_cast(bf16x8, w); }
        LDS_WAIT();
#pragma unroll
        for (int dt = 0; dt < 2; ++dt)
#pragma unroll
            for (int s2 = 0; s2 < 2; ++s2) {
                const v4i16_t lo = __builtin_amdgcn_ds_read_tr16_b64_v4i16((LAS v4i16_t*)(vr + (16 * s2) * VT_STRIDE + dt * 64));
                const v4i16_t hi = __builtin_amdgcn_ds_read_tr16_b64_v4i16((LAS v4i16_t*)(vr + (16 * s2 + 8) * VT_STRIDE + dt * 64));
                const bf16x8 vf = {lo[0], lo[1], lo[2], lo[3], hi[0], hi[1], hi[2], hi[3]};
                o[dt] = __builtin_amdgcn_mfma_f32_32x32x16_bf16(vf, pf[s2], o[dt], 0, 0, 0);
            }
        LDS_WAIT();
    }
}
struct KLoad4 { const bf16_t* base; size_t rs; int pos0, pstep, r, hh;
    DI void operator()(int kt, bf16x8 (&kf)[4]) const { const bf16_t* p = base + (size_t)(pos0 + pstep * (kt * 32 + r)) * rs + 8 * hh;
#pragma unroll
        for (int ks = 0; ks < 4; ++ks) kf[ks] = *(const bf16x8*)(p + 16 * ks); } };
struct KLoadMla { const bf16_t* nope; const bf16_t* rope; int r, hh;
    DI void operator()(int kt, bf16x8 (&kf)[6]) const { const int key = kt * 32 + r; const bf16_t* p = nope + (size_t)key * 1024 + 8 * hh; const bf16_t* q = rope + (size_t)key * OD_NP + 8 * hh;
#pragma unroll
        for (int ks = 0; ks < 4; ++ks) kf[ks] = *(const bf16x8*)(p + 16 * ks);
        kf[4] = *(const bf16x8*)q; kf[5] = *(const bf16x8*)(q + 16); } };
struct VLoad { const bf16_t* base; size_t rs; int pos0, pstep, lane;
    DI void operator()(int kt, u32x4 (&v)[4]) const {
#pragma unroll
        for (int i = 0; i < 4; ++i) v[i] = *(const u32x4*)(base + (size_t)(pos0 + pstep * (kt * 32 + i * 8 + (lane >> 3))) * rs + (lane & 7) * 8); } };
struct MaskCausal { int mq, hh; DI void operator()(int kt, f32x16& s) const {
#pragma unroll
        for (int i = 0; i < 16; ++i) if (kt * 32 + crow(i, hh) > mq) s[i] = -INFINITY; } };
struct MaskDil { int mq, hh; DI void operator()(int kt, f32x16& s) const {
#pragma unroll
        for (int i = 0; i < 16; ++i) { const int mk = kt * 32 + crow(i, hh); if (mk > mq || mq - mk > 128) s[i] = -INFINITY; } } };
struct MaskBits { const unsigned* mrow; int hh; DI void operator()(int kt, f32x16& s) const { const unsigned w = mrow[(size_t)kt * SEQ];
#pragma unroll
        for (int i = 0; i < 16; ++i) if (!((w >> crow(i, hh)) & 1u)) s[i] = -INFINITY; } };
DI void store_o(bf16_t* orow, const f32x16 (&o)[2], float inv, int hh) {
#pragma unroll
    for (int dt = 0; dt < 2; ++dt)
#pragma unroll
        for (int g = 0; g < 4; ++g) { u32x2 w; w.x = cvtpk(o[dt][4 * g] * inv, o[dt][4 * g + 1] * inv); w.y = cvtpk(o[dt][4 * g + 2] * inv, o[dt][4 * g + 3] * inv);
            *(u32x2*)(orow + 32 * dt + 8 * g + 4 * hh) = w; }
}
constexpr float LOG2E = 1.4426950408889634f;

constexpr int SCS = 2052;
DI void dsa_select_unit(Frame& F, const bf16_t* P, unsigned* maskT, int b, int g) {
    LAS float* sc = (LAS float*)F.lds;
    LAS unsigned* mst = (LAS unsigned*)(F.lds + 16 * SCS * 4);
    const int lane = F.lane, w = F.wave, qi = lane & 15, kq = lane >> 4, t0 = 16 * g;
    {
        const bf16_t* qrow = P + (size_t)(b * SEQ + t0 + qi) * EV_NP;
        bf16x8 qf[8];
#pragma unroll
        for (int h = 0; h < 8; ++h) qf[h] = *(const bf16x8*)(qrow + C_QI + h * 32 + 8 * kq);
        const u32x4 ww = *(const u32x4*)(qrow + C_WI);
        const float wv[8] = {bflo(ww.x), bfhi(ww.x), bflo(ww.y), bfhi(ww.y), bflo(ww.z), bfhi(ww.z), bflo(ww.w), bfhi(ww.w)};
        for (int kt = w; kt <= g; kt += 8) {
            const bf16x8 kf = *(const bf16x8*)(P + (size_t)(b * SEQ + kt * 16 + qi) * EV_NP + C_KI + 8 * kq);
            f32x4 s = {0.f, 0.f, 0.f, 0.f};
#pragma unroll
            for (int h = 0; h < 8; ++h) { const f32x4 d = __builtin_amdgcn_mfma_f32_16x16x32_bf16(kf, qf[h], (f32x4){0.f, 0.f, 0.f, 0.f}, 0, 0, 0);
#pragma unroll
                for (int r = 0; r < 4; ++r) s[r] += wv[h] * fmaxf(d[r], 0.f); }
            *(LAS f32x4*)(sc + qi * SCS + kt * 16 + 4 * kq) = s;
        }
    }
    __syncthreads();
    for (int qq = 0; qq < 2; ++qq) {
        const int q = 2 * w + qq, t = t0 + q;
        const LAS float* srow = sc + q * SCS;
        unsigned u[32];
#pragma unroll
        for (int e = 0; e < 32; ++e) { const int s = 64 * e + lane; const unsigned bits = __float_as_uint(srow[s]); const unsigned key = (bits & 0x80000000u) ? ~bits : (bits | 0x80000000u); u[e] = (s <= t) ? key : 0u; }
        unsigned mylo = 0u, myhi = 0u;
        if (t < 256) {
#pragma unroll
            for (int e = 0; e < 32; ++e) { const unsigned long long bal = __ballot(u[e] != 0u); if (lane == e) { mylo = (unsigned)bal; myhi = (unsigned)(bal >> 32); } }
        } else {
            unsigned T = 0u; bool exact = false;
            for (int bit = 31; bit >= 0; --bit) {
                const unsigned cand = T | (1u << bit); int cn = 0;
#pragma unroll
                for (int e = 0; e < 32; ++e) cn += __builtin_popcountll(__ballot(u[e] >= cand));
                if (cn >= 256) { T = cand; if (cn == 256) { exact = true; break; } }
            }
            if (exact) {
#pragma unroll
                for (int e = 0; e < 32; ++e) { const unsigned long long bal = __ballot(u[e] >= T); if (lane == e) { mylo = (unsigned)bal; myhi = (unsigned)(bal >> 32); } }
            } else {
                int cgt = 0;
#pragma unroll
                for (int e = 0; e < 32; ++e) cgt += __builtin_popcountll(__ballot(u[e] > T));
                const int need = 256 - cgt; int running = 0;
#pragma unroll
                for (int e = 0; e < 32; ++e) { const unsigned long long eq = __ballot(u[e] == T);
                    const int before = running + (int)__builtin_amdgcn_mbcnt_hi((unsigned)(eq >> 32), __builtin_amdgcn_mbcnt_lo((unsigned)eq, 0u));
                    const bool sel = (u[e] > T) || (u[e] == T && before < need);
                    const unsigned long long bal = __ballot(sel); if (lane == e) { mylo = (unsigned)bal; myhi = (unsigned)(bal >> 32); }
                    running += __builtin_popcountll(eq); }
            }
        }
        if (lane < 32) { mst[q * 64 + 2 * lane] = mylo; mst[q * 64 + 2 * lane + 1] = myhi; }
    }
    __syncthreads();
    for (int idx = F.tid; idx < 1024; idx += 512) { const int kt = idx >> 4, q = idx & 15; maskT[(size_t)(b * 64 + kt) * SEQ + t0 + q] = mst[q * 64 + kt]; }
    __syncthreads();
}
DI void dsa_attn_unit(Frame& F, const bf16_t* P, const unsigned* maskT, bf16_t* MIX, int bh, int j) {
    const int lane = F.lane, r = lane & 31, hh = lane >> 5, b = bh >> 3, hq = bh & 7, n = hq >> 2;
    const bf16_t* Pb = P + (size_t)b * SEQ * EV_NP;
    const int tq = 32 * j + r;
    bf16x8 qf[4];
#pragma unroll
    for (int ks = 0; ks < 4; ++ks) qf[ks] = *(const bf16x8*)(Pb + (size_t)tq * EV_NP + C_QA + hq * 64 + 16 * ks + 8 * hh);
    f32x16 o[2];
#pragma unroll
    for (int i = 0; i < 16; ++i) { o[0][i] = 0.f; o[1][i] = 0.f; }
    float m = -INFINITY, l = 0.f;
    wave_attn<4>(qf, 0, j + 1, KLoad4{Pb + C_KA + n * 64, (size_t)EV_NP, 0, 1, r, hh}, VLoad{Pb + C_VA + n * 64, (size_t)EV_NP, 0, 1, lane},
                 MaskBits{maskT + (size_t)b * 64 * SEQ + tq, hh}, 0.125f * LOG2E, F.lds + F.wave * VT_BYTES, lane, o, m, l);
    l += __shfl_xor(l, 32);
    store_o(MIX + (size_t)(b * SEQ + tq) * DM + hq * 64, o, 1.0f / l, hh);
}
DI void dil_attn_unit(Frame& F, const bf16_t* P, bf16_t* DO, float* DL, int br, int bh, int jt) {
    const int lane = F.lane, r = lane & 31, hh = lane >> 5, b = bh >> 3, h = bh & 7;
    const int d = (br == 0) ? 1 : (br == 1 ? 4 : 16), tpc = 64 / d, cls = jt / tpc, j = jt % tpc;
    const bf16_t* Pb = P + (size_t)b * SEQ * EV_NP;
    const int mq = 32 * j + r, tq = cls + d * mq;
    bf16x8 qf[4];
#pragma unroll
    for (int ks = 0; ks < 4; ++ks) qf[ks] = *(const bf16x8*)(Pb + (size_t)tq * EV_NP + C_QB + h * 64 + 16 * ks + 8 * hh);
    f32x16 o[2];
#pragma unroll
    for (int i = 0; i < 16; ++i) { o[0][i] = 0.f; o[1][i] = 0.f; }
    float m = -INFINITY, l = 0.f;
    wave_attn<4>(qf, (j - 4 > 0 ? j - 4 : 0), j + 1, KLoad4{Pb + C_KB + h * 64, (size_t)EV_NP, cls, d, r, hh}, VLoad{Pb + C_VB + h * 64, (size_t)EV_NP, cls, d, lane},
                 MaskDil{mq, hh}, 0.125f * LOG2E, F.lds + F.wave * VT_BYTES, lane, o, m, l);
    l += __shfl_xor(l, 32);
    const size_t tok = (size_t)(b * SEQ + tq);
    store_o(DO + ((size_t)br * MTOK + tok) * 512 + h * 64, o, 1.0f / l, hh);
    if (hh == 0) DL[((size_t)br * MTOK + tok) * 8 + h] = m * (0.125f * LOG2E) + __builtin_amdgcn_logf(l);
}
DI void phase_dil_merge(Frame& F, const bf16_t* DO, const float* DL, bf16_t* MIX) {
    for (int idx = F.gw * 64 + F.lane; idx < MTOK * 64; idx += F.NGW * 64) {
        const int tok = idx >> 6, h = (idx >> 3) & 7, c8 = idx & 7;
        float ls[3];
#pragma unroll
        for (int br = 0; br < 3; ++br) ls[br] = DL[((size_t)br * MTOK + tok) * 8 + h];
        const float mx = fmaxf(ls[0], fmaxf(ls[1], ls[2]));
        float wgt[3], ws = 0.f;
#pragma unroll
        for (int br = 0; br < 3; ++br) { wgt[br] = __builtin_amdgcn_exp2f(ls[br] - mx); ws += wgt[br]; }
        const float inv = 1.0f / ws;
        float acc[8];
#pragma unroll
        for (int k = 0; k < 8; ++k) acc[k] = 0.f;
#pragma unroll
        for (int br = 0; br < 3; ++br) { const u32x4 v = *(const u32x4*)(DO + ((size_t)br * MTOK + tok) * 512 + h * 64 + c8 * 8); const float wq = wgt[br] * inv;
            acc[0] += wq * bflo(v.x); acc[1] += wq * bfhi(v.x); acc[2] += wq * bflo(v.y); acc[3] += wq * bfhi(v.y); acc[4] += wq * bflo(v.z); acc[5] += wq * bfhi(v.z); acc[6] += wq * bflo(v.w); acc[7] += wq * bfhi(v.w); }
        u32x4 w; w.x = cvtpk(acc[0], acc[1]); w.y = cvtpk(acc[2], acc[3]); w.z = cvtpk(acc[4], acc[5]); w.w = cvtpk(acc[6], acc[7]);
        *(u32x4*)(MIX + (size_t)tok * DM + 512 + h * 64 + c8 * 8) = w;
    }
}
DI void mla_attn_unit(Frame& F, const bf16_t* Q2, const bf16_t* KV2, const bf16_t* P2, bf16_t* MIX, int bh, int j) {
    const int lane = F.lane, r = lane & 31, hh = lane >> 5, b = bh >> 3, h = bh & 7;
    const int tq = 32 * j + r; const size_t tok = (size_t)(b * SEQ + tq);
    bf16x8 qf[6];
#pragma unroll
    for (int ks = 0; ks < 4; ++ks) qf[ks] = *(const bf16x8*)(Q2 + tok * 768 + h * 64 + 16 * ks + 8 * hh);
    qf[4] = *(const bf16x8*)(Q2 + tok * 768 + 512 + h * 32 + 8 * hh); qf[5] = *(const bf16x8*)(Q2 + tok * 768 + 512 + h * 32 + 16 + 8 * hh);
    f32x16 o[2];
#pragma unroll
    for (int i = 0; i < 16; ++i) { o[0][i] = 0.f; o[1][i] = 0.f; }
    float m = -INFINITY, l = 0.f;
    const bf16_t* kvb = KV2 + (size_t)b * SEQ * 1024 + h * 128;
    wave_attn<6>(qf, 0, j + 1, KLoadMla{kvb, P2 + (size_t)b * SEQ * OD_NP + C_KR, r, hh}, VLoad{kvb + 64, (size_t)1024, 0, 1, lane},
                 MaskCausal{tq, hh}, 0.10206207261596577f * LOG2E, F.lds + F.wave * VT_BYTES, lane, o, m, l);
    l += __shfl_xor(l, 32);
    store_o(MIX + tok * DM + h * 64, o, 1.0f / l, hh);
}
DI void phase_mla_norm(Frame& F, int li, const bf16_t* P2, bf16_t* CQN, bf16_t* CKVN) {
    const float* gq = F.in[10] + li * 256; const float* gkv = F.in[12] + li * 128;
    const f32x4 g4 = *(const f32x4*)(gq + 4 * F.lane); const f32x2 g2 = *(const f32x2*)(gkv + 2 * F.lane);
    for (int row = F.gw; row < MTOK; row += F.NGW) {
        const u32x2 a = *(const u32x2*)(P2 + (size_t)row * OD_NP + C_CQ + 4 * F.lane); const unsigned kv = *(const unsigned*)(P2 + (size_t)row * OD_NP + C_CKV + 2 * F.lane);
        const float q0 = bflo(a.x), q1 = bfhi(a.x), q2 = bflo(a.y), q3 = bfhi(a.y), k0 = bflo(kv), k1 = bfhi(kv);
        const float sq = wave_sum(q0 * q0 + q1 * q1 + q2 * q2 + q3 * q3), sk = wave_sum(k0 * k0 + k1 * k1);
        const float rq = 1.0f / sqrtf(sq * (1.0f / 256.0f) + 1e-6f), rk = 1.0f / sqrtf(sk * (1.0f / 128.0f) + 1e-6f);
        u32x2 w; w.x = cvtpk(q0 * rq * g4[0], q1 * rq * g4[1]); w.y = cvtpk(q2 * rq * g4[2], q3 * rq * g4[3]);
        *(u32x2*)(CQN + (size_t)row * 256 + 4 * F.lane) = w;
        *(unsigned*)(CKVN + (size_t)row * 256 + 2 * F.lane) = cvtpk(k0 * rk * g2[0], k1 * rk * g2[1]);
        *(unsigned*)(CKVN + (size_t)row * 256 + 128 + 2 * F.lane) = 0u;
    }
}
constexpr int XS_STRIDE = 68, XS_BYTES = 32 * XS_STRIDE * 4;
template <bool FINAL> DI void rg_unit(Frame& F, int li, int b, int k, int n, const bf16_t* P2, const bf16_t* wt, float* agg, bf16_t* MIX) {
    const int lane = F.lane, r = lane & 31, hh = lane >> 5, t0 = 32 * k, row0 = b * SEQ + t0;
    LAS float* xs = (LAS float*)(F.lds + 65536 + F.wave * XS_BYTES);
    const float* cw = F.in[14] + li * 4 * 512; const float* cb = F.in[15] + li * 512; const float* ba = F.in[17] + li * 512; const float* bx = F.in[19] + li * 512; const float* lam = F.in[20] + li * 512;
    bf16x8 af[4];
#pragma unroll
    for (int ks = 0; ks < 4; ++ks) {
        const int ch = n * 64 + 16 * ks + 8 * hh;
        float xc[8]; { const f32x4 c0 = *(const f32x4*)(cb + ch), c1 = *(const f32x4*)(cb + ch + 4); xc[0] = c0[0]; xc[1] = c0[1]; xc[2] = c0[2]; xc[3] = c0[3]; xc[4] = c1[0]; xc[5] = c1[1]; xc[6] = c1[2]; xc[7] = c1[3]; }
#pragma unroll
        for (int w = 0; w < 4; ++w) { const int tt = t0 + r - 3 + w;
            if (tt >= 0) { const u32x4 xv = *(const u32x4*)(P2 + (size_t)(b * SEQ + tt) * OD_NP + C_XR + ch); const f32x4 w0 = *(const f32x4*)(cw + w * 512 + ch), w1 = *(const f32x4*)(cw + w * 512 + ch + 4);
                xc[0] += w0[0] * bflo(xv.x); xc[1] += w0[1] * bfhi(xv.x); xc[2] += w0[2] * bflo(xv.y); xc[3] += w0[3] * bfhi(xv.y); xc[4] += w1[0] * bflo(xv.z); xc[5] += w1[1] * bfhi(xv.z); xc[6] += w1[2] * bflo(xv.w); xc[7] += w1[3] * bfhi(xv.w); } }
        u32x4 w; w.x = cvtpk(xc[0], xc[1]); w.y = cvtpk(xc[2], xc[3]); w.z = cvtpk(xc[4], xc[5]); w.w = cvtpk(xc[6], xc[7]); af[ks] = __builtin_bit_cast(bf16x8, w);
        *(LAS f32x4*)(xs + r * XS_STRIDE + 16 * ks + 8 * hh) = (f32x4){xc[0], xc[1], xc[2], xc[3]}; *(LAS f32x4*)(xs + r * XS_STRIDE + 16 * ks + 8 * hh + 4) = (f32x4){xc[4], xc[5], xc[6], xc[7]};
    }
    LDS_WAIT();
#pragma unroll
    for (int jn = 0; jn < 2; ++jn) {
        f32x16 da, dx;
#pragma unroll
        for (int i = 0; i < 16; ++i) { da[i] = 0.f; dx[i] = 0.f; }
#pragma unroll
        for (int ks = 0; ks < 4; ++ks) { const bf16x8 wa = *(const bf16x8*)(wt + (size_t)((n * 64 + jn * 32 + r) * 64) + 16 * ks + 8 * hh), wx = *(const bf16x8*)(wt + (size_t)(((8 + n) * 64 + jn * 32 + r) * 64) + 16 * ks + 8 * hh);
            da = __builtin_amdgcn_mfma_f32_32x32x16_bf16(af[ks], wa, da, 0, 0, 0); dx = __builtin_amdgcn_mfma_f32_32x32x16_bf16(af[ks], wx, dx, 0, 0, 0); }
        const int ch = n * 64 + jn * 32 + r;
        const float cl = -8.0f * log1pf(__expf(-lam[ch])), bav = ba[ch], bxv = bx[ch];
        float a[16], u[16];
#pragma unroll
        for (int i = 0; i < 16; ++i) { const int tok = crow(i, hh);
            const float rr = 1.0f / (1.0f + __expf(-(da[i] + bav))), ig = 1.0f / (1.0f + __expf(-(dx[i] + bxv))), xcv = xs[tok * XS_STRIDE + jn * 32 + r];
            const float la = cl * rr; a[i] = __expf(la); u[i] = sqrtf(-expm1f(2.0f * la)) * (ig * xcv); }
        float Ag[4], Hg[4];
#pragma unroll
        for (int g = 0; g < 4; ++g) { float A = 1.f, H = 0.f;
#pragma unroll
            for (int e = 0; e < 4; ++e) { A *= a[4 * g + e]; H = a[4 * g + e] * H + u[4 * g + e]; } Ag[g] = A; Hg[g] = H; }
        float hin = 0.f;
        if (FINAL) { for (int kk = 0; kk < k; ++kk) { const f32x2 ah = *(const f32x2*)(agg + ((size_t)(b * 64 + kk) * 512 + ch) * 2); hin = ah[0] * hin + ah[1]; } }
        float S = hin, Aall = 1.f, st[4];
#pragma unroll
        for (int g = 0; g < 4; ++g) { const float pA = __shfl_xor(Ag[g], 32), pH = __shfl_xor(Hg[g], 32);
            const float A0 = hh ? pA : Ag[g], H0 = hh ? pH : Hg[g], A1 = hh ? Ag[g] : pA, H1 = hh ? Hg[g] : pH;
            const float s0 = S; S = A0 * S + H0; const float s1 = S; S = A1 * S + H1; Aall *= A0 * A1; st[g] = hh ? s1 : s0; }
        if (!FINAL) { if (hh == 0) *(f32x2*)(agg + ((size_t)(b * 64 + k) * 512 + ch) * 2) = (f32x2){Aall, S}; }
        else {
#pragma unroll
            for (int g = 0; g < 4; ++g) { float hcur = st[g];
#pragma unroll
                for (int e = 0; e < 4; ++e) { const int i = 4 * g + e, tok = crow(i, hh); hcur = a[i] * hcur + u[i];
                    const float gt = bf2f(P2[(size_t)(row0 + tok) * OD_NP + C_GR + ch]);
                    const float y = 0.7978845608028654f * (gt + 0.044715f * gt * gt * gt), th = 1.0f - 2.0f / (1.0f + __expf(2.0f * y)), ge = 0.5f * gt * (1.0f + th);
                    MIX[(size_t)(row0 + tok) * DM + 512 + ch] = (bf16_t)(cvtpk(hcur * ge, 0.f) & 0xffffu); } }
        }
    }
    LDS_WAIT();
}

constexpr int NPH_PAIR = 18, NPH = 2 * NPH_PAIR + 1;
#ifndef PH_EN
#define PH_EN 0x3ffffull
#endif
#define IN(k) ((((PH_EN) >> (((k) >= 2 * NPH_PAIR) ? 0 : ((k) % NPH_PAIR))) & 1ull) && args.ph_lo <= (k) && (k) < args.ph_hi)
#define SEAM(k) do { if (IN(k) && IN((k) + 1)) { XcdBarrier bar; bar.bar = (unsigned*)(args.ws + WS_CTL) + CW_BAR; bar.x = xb_xcc_id(); bar.st = (volatile LAS unsigned*)(F.lds + LDS_MISC_OFF) + 8; xcd_barrier(bar); } } while (0)
#define X ((float*)(ws + WS_X))
#define H ((bf16_t*)(ws + WS_H))
#define MIX ((bf16_t*)(ws + WS_MIX))
#define P ((bf16_t*)(ws + WS_PY))
#define P2 ((bf16_t*)(ws + WS_PY + PY_P2))
#define CQN ((bf16_t*)(ws + WS_PY + PY_CQN))
#define CKVN ((bf16_t*)(ws + WS_PY + PY_CKVN))
#define Q2 ((bf16_t*)(ws + WS_PY + PY_Q2))
#define KV2 ((bf16_t*)(ws + WS_PY + PY_KV2))
#define XR ((bf16_t*)(ws + WS_PY + PY_XR))
#define Y ((float*)(ws + WS_PY + PY_Y))
#define ACT ((bf16_t*)(ws + WS_BIG))
#define DO ((bf16_t*)(ws + WS_BIG + BIG_DIL))
#define DL ((float*)(ws + WS_BIG + BIG_DIL + 48 * MiB))
#define maskT ((unsigned*)(ws + WS_MISC + MISC_MASK))
#define agg ((float*)(ws + WS_MISC + MISC_AGG))
#define rope ((const float*)(ws + WS_ROPE))
#define we ((const bf16_t*)(ws + WS_WE))
#define wo ((const bf16_t*)(ws + WS_WO))
#define PHASE_WS unsigned char* ws = args.ws; asm volatile("" : "+s"(ws)); F.ws = ws; { int t_ = threadIdx.x, b_ = blockIdx.x, g_ = gridDim.x; asm volatile("" : "+v"(t_), "+s"(b_), "+s"(g_)); \
    F.tid = t_; F.lane = t_ & 63; F.wave = __builtin_amdgcn_readfirstlane(t_ >> 6); F.G = g_; F.vcu = (g_ % 8 == 0) ? (b_ % 8) * (g_ / 8) + b_ / 8 : b_; F.gw = F.vcu * 8 + F.wave; F.NGW = g_ * 8; }

template <int lp> DI void pair_body(Frame& F, const Args& args) {
    constexpr int pb = lp * NPH_PAIR;
        if (IN(pb + 0)) { PHASE_WS
            phase_cvt_even(F, lp);
            if (lp == 0) { phase_rope_tables(F); phase_norm<0>(F, args.in[0], args.in[1], H, nullptr); }
            else phase_norm<1>(F, nullptr, args.in[1] + DM, H, nullptr);
        }
        SEAM(pb + 0);
        if (IN(pb + 1)) { PHASE_WS
            pg8::Gemm g{H, we + WE_IN / 2, DM, DM, 0}; pg8::StaticOrder S; S.init(MTOK, EV_NP, F.G, (int)blockIdx.x);
            pg8::EpiBf16<1> E{P, EV_NP, rope};
            pg8::gemm_phase<pg8::EpiBf16<1>, pg8::StaticOrder, true>(F.lds, g, S, E);
        }
        SEAM(pb + 1);
        if (IN(pb + 2)) { PHASE_WS
            { const int bb = F.vcu >> 5, i = F.vcu & 31;
              if (F.G == 256) { dsa_select_unit(F, P, maskT, bb, i); dsa_select_unit(F, P, maskT, bb, 63 - i); dsa_select_unit(F, P, maskT, bb, 64 + i); dsa_select_unit(F, P, maskT, bb, 127 - i); }
              else for (int u = F.vcu; u < 1024; u += F.G) dsa_select_unit(F, P, maskT, u >> 7, u & 127); }
            for (int u = F.gw; u < 3 * 4096; u += F.NGW) {
                const int br = u / 4096, q = u % 4096, bh = q >> 6; int jt = q & 63; jt = (jt & 1) ? 63 - (jt >> 1) : (jt >> 1);
                dil_attn_unit(F, P, DO, DL, br, bh, jt); }
        }
        SEAM(pb + 2);
        if (IN(pb + 3)) { PHASE_WS
            for (int u = F.gw; u < 4096; u += F.NGW) { const int bh = u >> 6; int j = u & 63; j = (j & 1) ? 63 - (j >> 1) : (j >> 1); dsa_attn_unit(F, P, maskT, MIX, bh, j); }
            phase_dil_merge(F, DO, DL, MIX);
        }
        SEAM(pb + 3);
        if (IN(pb + 4)) { PHASE_WS
            pg8::Gemm g{MIX, we + WE_OUT / 2, DM, DM, 0}; pg8::StaticOrder S; S.init(MTOK, DM, F.G, (int)blockIdx.x);
            pg8::EpiF32 E{X, lp == 0 ? args.in[0] : X, DM};
            pg8::gemm_phase<pg8::EpiF32, pg8::StaticOrder, true>(F.lds, g, S, E);
        }
        SEAM(pb + 4);
        if (IN(pb + 5)) { PHASE_WS phase_norm<0>(F, X, args.in[4] + lp * DM, H, nullptr); }
        SEAM(pb + 5);
        if (IN(pb + 6)) { PHASE_WS
            pg8::Gemm g{H, we + WE_GU / 2, DM, DM, 0}; pg8::StaticOrder S; S.init(MTOK, 2 * DFF, F.G, (int)blockIdx.x);
            pg8::EpiSwiGLU E{ACT};
            pg8::gemm_phase<pg8::EpiSwiGLU, pg8::StaticOrder, true>(F.lds, g, S, E);
        }
        SEAM(pb + 6);
        if (IN(pb + 7)) { PHASE_WS
            pg8::Gemm g{ACT, we + WE_DN / 2, DFF, DFF, 0}; pg8::StaticOrder S; S.init(MTOK, DM, F.G, (int)blockIdx.x);
            pg8::EpiF32 E{X, X, DM};
            pg8::gemm_phase<pg8::EpiF32, pg8::StaticOrder, true>(F.lds, g, S, E);
        }
        SEAM(pb + 7);
        if (IN(pb + 8)) { PHASE_WS phase_cvt_odd(F, lp); phase_norm<0>(F, X, args.in[8] + lp * DM, H, nullptr); }
        SEAM(pb + 8);
        if (IN(pb + 9)) { PHASE_WS
            pg8::Gemm g{H, wo + WO_IN / 2, DM, DM, 0}; pg8::StaticOrder S; S.init(MTOK, OD_NP, F.G, (int)blockIdx.x);
            pg8::EpiBf16<2> E{P2, OD_NP, rope};
            pg8::gemm_phase<pg8::EpiBf16<2>, pg8::StaticOrder, true>(F.lds, g, S, E);
        }
        SEAM(pb + 9);
        if (IN(pb + 10)) { PHASE_WS
            phase_mla_norm(F, lp, P2, CQN, CKVN);
            for (int u = F.gw; u < 4096; u += F.NGW) rg_unit<false>(F, lp, u >> 9, (u >> 3) & 63, u & 7, P2, wo + WO_RG / 2, agg, MIX);
        }
        SEAM(pb + 10);
        if (IN(pb + 11)) { PHASE_WS
            { pg8::Gemm g{CQN, wo + WO_UQ / 2, 256, 256, 0}; pg8::StaticOrder S; S.init(MTOK, 768, F.G, (int)blockIdx.x);
              pg8::EpiBf16<3> E{Q2, 768, rope};
              pg8::gemm_phase<pg8::EpiBf16<3>, pg8::StaticOrder, true>(F.lds, g, S, E); }
            { pg8::Gemm g{CKVN, wo + WO_UKV / 2, 256, 256, 0}; pg8::StaticOrder S; S.init(MTOK, 1024, F.G, (int)blockIdx.x);
              pg8::EpiBf16<0> E{KV2, 1024, rope};
              pg8::gemm_phase<pg8::EpiBf16<0>, pg8::StaticOrder, true>(F.lds, g, S, E); }
        }
        SEAM(pb + 11);
        if (IN(pb + 12)) { PHASE_WS
            for (int u = F.gw; u < 4096; u += F.NGW) { const int bh = u >> 6; int j = u & 63; j = (j & 1) ? 63 - (j >> 1) : (j >> 1); mla_attn_unit(F, Q2, KV2, P2, MIX, bh, j); }
            for (int u = F.gw; u < 4096; u += F.NGW) rg_unit<true>(F, lp, u >> 9, (u >> 3) & 63, u & 7, P2, wo + WO_RG / 2, agg, MIX);
        }
        SEAM(pb + 12);
        if (IN(pb + 13)) { PHASE_WS
            pg8::Gemm g{MIX, wo + WO_OUT / 2, DM, DM, 0}; pg8::StaticOrder S; S.init(MTOK, DM, F.G, (int)blockIdx.x);
            pg8::EpiF32 E{X, X, DM};
            pg8::gemm_phase<pg8::EpiF32, pg8::StaticOrder, true>(F.lds, g, S, E);
        }
        SEAM(pb + 13);
        if (IN(pb + 14)) { PHASE_WS phase_norm_route(F, lp, args.in[22] + lp * DM, H); }
        SEAM(pb + 14);
        if (IN(pb + 15)) { PHASE_WS phase_moe_scatter(F, lp, H); }
        SEAM(pb + 15);
        if (IN(pb + 16)) { PHASE_WS
            pg8::MoeOrder S; moe_tiles(F, lp, S.ts); S.nN = 2 * DFF / 256; S.nwg = S.ts[8] * S.nN; S.G = F.G; S.c = (int)blockIdx.x;
            pg8::Gemm g{XR, wo + WO_MGU / 2, DM, DM, (size_t)2 * DFF * DM};
            pg8::EpiSwiGLU E{ACT};
            pg8::gemm_phase<pg8::EpiSwiGLU, pg8::MoeOrder, true>(F.lds, g, S, E);
        }
        SEAM(pb + 16);
        if (IN(pb + 17)) { PHASE_WS
            pg8::MoeOrder S; moe_tiles(F, lp, S.ts); S.nN = DM / 256; S.nwg = S.ts[8] * S.nN; S.G = F.G; S.c = (int)blockIdx.x;
            pg8::Gemm g{ACT, wo + WO_MDN / 2, DFF, DFF, (size_t)DM * DFF};
            pg8::EpiF32 E{Y, nullptr, DM};
            pg8::gemm_phase<pg8::EpiF32, pg8::MoeOrder, true>(F.lds, g, S, E);
        }
        SEAM(pb + 17);
    }

__global__ void __launch_bounds__(512, 2) fwd(Args args) {
    extern __shared__ __attribute__((aligned(16))) unsigned char lds_raw[];
    Frame F;
    F.lds = (LAS unsigned char*)lds_raw; F.ws = args.ws; F.in = args.in;
    F.tid = threadIdx.x; F.lane = F.tid & 63; F.wave = __builtin_amdgcn_readfirstlane(F.tid >> 6);
    F.G = gridDim.x; { const int bx = blockIdx.x; F.vcu = (F.G % 8 == 0) ? (bx % 8) * (F.G / 8) + bx / 8 : bx; }
    F.gw = F.vcu * 8 + F.wave; F.NGW = F.G * 8;
    { volatile LAS unsigned* MISC = (volatile LAS unsigned*)(F.lds + LDS_MISC_OFF);
      for (int u = F.tid; u < (LDS_BYTES - LDS_MISC_OFF) / 4; u += 512) MISC[u] = 0u;
      __syncthreads();
      if (args.ph_hi - args.ph_lo > 1) (void)xcd_barrier_post((unsigned*)(args.ws + WS_CTL) + CW_BAR, MISC + 8); }
    pair_body<0>(F, args);
    pair_body<1>(F, args);
    if (IN(2 * NPH_PAIR)) { PHASE_WS phase_norm<2>(F, nullptr, args.in[27], nullptr, args.out); }
#undef IN
#undef SEAM
}

extern "C" void kernel_launch(void* const* d_in, const int* in_sizes, int n_in, void* d_out, int out_size, void* d_ws, size_t ws_size, hipStream_t stream) {
    static int grid = 0;
    if (grid == 0) {
        if (n_in != 28 || out_size != MTOK * DM || ws_size < WS_END) { fprintf(stderr, "kernel_launch: unexpected shapes (n_in %d, out %d, ws %zu)\n", n_in, out_size, ws_size); grid = -1; return; }
        int dev = 0, cus = 0, per_cu = 0;
        if (hipGetDevice(&dev) != hipSuccess || hipDeviceGetAttribute(&cus, hipDeviceAttributeMultiprocessorCount, dev) != hipSuccess) { grid = -1; return; }
        if (hipFuncSetAttribute((const void*)fwd, hipFuncAttributeMaxDynamicSharedMemorySize, LDS_BYTES) != hipSuccess) { fprintf(stderr, "kernel_launch: hipFuncSetAttribute failed\n"); grid = -1; return; }
        if (hipOccupancyMaxActiveBlocksPerMultiprocessor(&per_cu, (const void*)fwd, 512, LDS_BYTES) != hipSuccess || per_cu < 1) fprintf(stderr, "kernel_launch: occupancy query reports %d\n", per_cu);
        (void)hipGetLastError();
        grid = cus;
    }
    if (grid < 0) return;
    (void)hipMemsetAsync((char*)d_ws + WS_CTL, 0, CTL_ZERO_BYTES, stream);
    Args a{};
    for (int i = 0; i < 28; ++i) a.in[i] = (const float*)d_in[i];
    a.out = (float*)d_out; a.ws = (unsigned char*)d_ws;
#if MK_MULTI
#ifndef MK_PHMAX
#define MK_PHMAX NPH
#endif
    for (int p = 0; p < MK_PHMAX; ++p) { a.ph_lo = p; a.ph_hi = p + 1; hipLaunchKernelGGL(fwd, dim3(grid), dim3(512), LDS_BYTES, stream, a); }
#else
    a.ph_lo = 0; a.ph_hi = NPH; hipLaunchKernelGGL(fwd, dim3(grid), dim3(512), LDS_BYTES, stream, a);
#endif
}
```

```cpp
#include <hip/hip_runtime.h>
#include <cstdio>
#include <cstdint>
#include <cmath>

#ifndef MK_MULTI
#define MK_MULTI 0
#endif

#ifndef REP_SC
#define REP_SC 1
#endif
#ifndef REP_SL
#define REP_SL 1
#endif
#ifndef REP_SEL
#define REP_SEL 1
#endif
#ifndef REP_DIL
#define REP_DIL 1
#endif
#ifndef REP_DSA
#define REP_DSA 1
#endif
#ifndef REP_MLA
#define REP_MLA 1
#endif
#ifndef REP_RG1
#define REP_RG1 1
#endif
#ifndef REP_RG2
#define REP_RG2 1
#endif
#ifndef PROBE_G
#define PROBE_G 0
#endif
#define DI __device__ __forceinline__
#define LAS __attribute__((address_space(3)))
#define GAS __attribute__((address_space(1)))
typedef unsigned short bf16_t;
typedef short bf16x8 __attribute__((ext_vector_type(8)));
typedef short s16x4 __attribute__((ext_vector_type(4)));
typedef float f32x2 __attribute__((ext_vector_type(2)));
typedef float f32x4 __attribute__((ext_vector_type(4)));
typedef float f32x16 __attribute__((ext_vector_type(16)));
typedef unsigned u32x2 __attribute__((ext_vector_type(2)));
typedef unsigned u32x4 __attribute__((ext_vector_type(4)));
typedef int i32x4 __attribute__((ext_vector_type(4)));
typedef __bf16 bf16x2_t __attribute__((ext_vector_type(2)));

constexpr int SEQ = 2048, BATCH = 8, DM = 1024, MTOK = BATCH * SEQ;
constexpr int EV_N = 2600, EV_NP = 2816;
constexpr int OD_N = 1440, OD_NP = 1536;
constexpr int DFF = 3584;
constexpr int NEXP = 8;
constexpr int MOE_ROWS = 2 * MTOK + NEXP * 256;
constexpr int C_QA = 0, C_KA = 512, C_VA = 640, C_QB = 768, C_KB = 1280, C_VB = 1792, C_QI = 2304, C_KI = 2560, C_WI = 2592;
constexpr int C_CQ = 0, C_CKV = 256, C_KR = 384, C_XR = 512, C_GR = 1024;

constexpr size_t MiB = 1u << 20;
constexpr size_t WS_CTL = 0, CTL_ZERO_BYTES = 1 * MiB;
constexpr size_t WS_ROPE = 1 * MiB;
constexpr size_t WS_WE = 2 * MiB;
constexpr size_t WE_IN = 0, WE_OUT = 6 * MiB, WE_GU = 8 * MiB, WE_DN = 23 * MiB;
constexpr size_t WS_WO = 34 * MiB;
constexpr size_t WO_IN = 0, WO_UQ = 3 * MiB, WO_UKV = 4 * MiB, WO_OUT = 5 * MiB, WO_RG = 7 * MiB, WO_MGU = 8 * MiB, WO_MDN = 120 * MiB;
constexpr size_t WS_X = 218 * MiB;
constexpr size_t WS_H = 282 * MiB;
constexpr size_t WS_MIX = 314 * MiB;
constexpr size_t WS_PY = 346 * MiB;
constexpr size_t PY_P2 = 0, PY_CQN = 48 * MiB, PY_CKVN = 56 * MiB, PY_Q2 = 64 * MiB, PY_KV2 = 88 * MiB;
constexpr size_t PY_XR = 0, PY_Y = 68 * MiB;
constexpr size_t WS_BIG = 550 * MiB;
constexpr size_t BIG_DIL = 128 * MiB;
constexpr size_t WS_MISC = 788 * MiB;
constexpr size_t MISC_MASK = 0, MISC_AGG = 4 * MiB, MISC_RT = 6 * MiB;
constexpr size_t WS_Q8M = 796 * MiB;
constexpr size_t WS_Q8D = 852 * MiB;
constexpr size_t WS_SB = 859 * MiB;
constexpr size_t WS_Q8O = 860 * MiB;
constexpr size_t WS_Q8E = 862 * MiB;
constexpr size_t WS_END = 866 * MiB;

constexpr int CW_BAR = 4096;
constexpr int CW_CNT = 64;
constexpr size_t CTL_CMAX_D = 64 * 1024, CTL_CMAX_M = 128 * 1024;
constexpr size_t RT_SAG = 1024 * 1024;
constexpr size_t RT_SA = 940 * 1024;

constexpr int LDS_MISC_OFF = 143360;
constexpr int LDS_BYTES = 147456;

DI unsigned cvtpk(float lo, float hi) { f32x2 v = {lo, hi}; bf16x2_t b = __builtin_convertvector(v, bf16x2_t); return __builtin_bit_cast(unsigned, b); }
DI float bf2f(unsigned b) { return __uint_as_float(b << 16); }
DI float bflo(unsigned w) { return __uint_as_float(w << 16); }
DI float bfhi(unsigned w) { return __uint_as_float(w & 0xffff0000u); }
DI float wave_sum(float v) {
#define WS_STEP(ctrl, rm) v += __builtin_bit_cast(float, __builtin_amdgcn_update_dpp(0, __builtin_bit_cast(int, v), ctrl, rm, 0xf, true))
    WS_STEP(0x111, 0xf); WS_STEP(0x112, 0xf); WS_STEP(0x114, 0xf); WS_STEP(0x118, 0xf); WS_STEP(0x142, 0xa); WS_STEP(0x143, 0xc);
#undef WS_STEP
    return __builtin_bit_cast(float, __builtin_amdgcn_readlane(__builtin_bit_cast(int, v), 63));
}
DI float wave_max(float v) {
#define WM_STEP(ctrl, rm) v = fmaxf(v, __builtin_bit_cast(float, __builtin_amdgcn_update_dpp(__builtin_bit_cast(int, v), __builtin_bit_cast(int, v), ctrl, rm, 0xf, false)))
    WM_STEP(0x111, 0xf); WM_STEP(0x112, 0xf); WM_STEP(0x114, 0xf); WM_STEP(0x118, 0xf); WM_STEP(0x142, 0xa); WM_STEP(0x143, 0xc);
#undef WM_STEP
    return __builtin_bit_cast(float, __builtin_amdgcn_readlane(__builtin_bit_cast(int, v), 63));
}
DI int wave_sum_i32(int v) {
    v += __builtin_amdgcn_update_dpp(0, v, 0x111, 0xf, 0xf, true);
    v += __builtin_amdgcn_update_dpp(0, v, 0x112, 0xf, 0xf, true);
    v += __builtin_amdgcn_update_dpp(0, v, 0x114, 0xf, 0xf, true);
    v += __builtin_amdgcn_update_dpp(0, v, 0x118, 0xf, 0xf, true);
    v += __builtin_amdgcn_update_dpp(0, v, 0x142, 0xa, 0xf, true);
    v += __builtin_amdgcn_update_dpp(0, v, 0x143, 0xc, 0xf, true);
    return __builtin_amdgcn_readlane(v, 63);
}
DI float xhalf_max(float v) { const auto rr = __builtin_amdgcn_permlane32_swap(__float_as_uint(v), __float_as_uint(v), false, false); return fmaxf(__uint_as_float(rr[0]), __uint_as_float(rr[1])); }
DI float xhalf_sum(float v) { const auto rr = __builtin_amdgcn_permlane32_swap(__float_as_uint(v), __float_as_uint(v), false, false); return __uint_as_float(rr[0]) + __uint_as_float(rr[1]); }
DI float tree_max16(const f32x16& s) {
    const float a0 = fmaxf(fmaxf(s[0], s[1]), s[2]), a1 = fmaxf(fmaxf(s[3], s[4]), s[5]), a2 = fmaxf(fmaxf(s[6], s[7]), s[8]), a3 = fmaxf(fmaxf(s[9], s[10]), s[11]), a4 = fmaxf(fmaxf(s[12], s[13]), s[14]);
    return fmaxf(fmaxf(fmaxf(a0, a1), a2), fmaxf(fmaxf(a3, a4), s[15]));
}
DI float tree_sum16(const f32x16& s) {
    const float a0 = s[0] + s[1], a1 = s[2] + s[3], a2 = s[4] + s[5], a3 = s[6] + s[7], a4 = s[8] + s[9], a5 = s[10] + s[11], a6 = s[12] + s[13], a7 = s[14] + s[15];
    return ((a0 + a1) + (a2 + a3)) + ((a4 + a5) + (a6 + a7));
}
DI int crow(int i, int hh) { return (i & 3) + 8 * (i >> 2) + 4 * hh; }
#define LDS_WAIT() asm volatile("s_waitcnt lgkmcnt(0)" ::: "memory")
#define VM_WAIT() asm volatile("s_waitcnt vmcnt(0)" ::: "memory")

namespace pg8 {
constexpr int BM = 256, BK = 64, HALF = 128, HTB = HALF * BK * 2, STAGE_BYTES = 8 * HTB, NXCD = 8, WGM = 4;
__host__ __device__ __forceinline__ int lds_byte(int r, int c) { const int st = (r >> 4) * 2 + (c >> 5), rr = r & 15, cc = c & 31, ob = rr * 64 + cc * 2; return st * 1024 + (ob ^ (((ob >> 9) & 1) << 5)); }
__host__ __device__ __forceinline__ void stage_rc(int b, int& R, int& C) { const int st = b / 1024, sb = b % 1024, swz = sb ^ (((sb >> 9) & 1) << 5); R = (st >> 1) * 16 + swz / 64; C = (st & 1) * 32 + (swz % 64) / 2; }
__host__ __device__ __forceinline__ int perm32(int rho) { const int n = rho >> 4, i = rho & 15; return 8 * (i >> 2) + 4 * n + (i & 3); }

struct Unit { int pm, pn, e; };
struct Gemm { const bf16_t* A; const bf16_t* Bt; int lda; int K; size_t estride; int ldb; const int* rowtok; };

__device__ __forceinline__ int xcd_remap(int L, int nwg) { const int q = nwg / NXCD, r = nwg % NXCD, xcd = L % NXCD, off = L / NXCD; return (xcd < r ? xcd * (q + 1) : r * (q + 1) + (xcd - r) * q) + off; }

struct StaticOrder {
    int nM, nN, nwg, G, c;
    __device__ void init(int M, int N, int G_, int c_) { nM = M / BM; nN = N / BM; nwg = nM * nN; G = G_; c = c_; }
    __device__ bool next(int i, Unit& u) const {
        const long L = (long)i * G + c; if (L >= nwg) return false;
        const int wgid = xcd_remap((int)L, nwg);
        const int nig = WGM * nN, gid = wgid / nig, fm = gid * WGM, gsz = (nM - fm) < WGM ? (nM - fm) : WGM;
        u.pm = fm + ((wgid % nig) % gsz); u.pn = (wgid % nig) / gsz; u.e = 0; return true;
    }
};
struct MoeOrder {
    int nN, nwg, G, c; int ts[9];
    __device__ bool next(int i, Unit& u) const {
        const long L = (long)i * G + c; if (L >= nwg) return false;
        const int wgid = xcd_remap((int)L, nwg);
        const int nig = WGM * nN, gid = wgid / nig, fm = gid * WGM, nM = ts[8], gsz = (nM - fm) < WGM ? (nM - fm) : WGM;
        u.pm = fm + ((wgid % nig) % gsz); u.pn = (wgid % nig) / gsz;
        int e = 0;
#pragma unroll
        for (int j = 1; j < 8; ++j) e += (u.pm >= ts[j]) ? 1 : 0;
        u.e = e; return true;
    }
};

struct SplitOrder {
    int nitems, c; int ts[9];
    __device__ bool next(int i, Unit& u) const {
        if (i > 0 || c >= nitems) return false;
        const int unit = c / 7; u.pm = 128 + (unit >> 2); u.pn = unit & 3;
        int e = 0;
#pragma unroll
        for (int j = 1; j < 8; ++j) e += (u.pm >= ts[j]) ? 1 : 0;
        u.e = e; return true;
    }
};

#ifndef PROBE_GATE
#define PROBE_GATE (GATHER)
#endif
template <class Epi, class Sched, bool ALIGN_EPI, bool GATHER = false, bool INT8 = false>
__device__ __forceinline__ void gemm_phase(LAS unsigned char* lds, const Gemm g, const Sched& S, const Epi& E) {
    int tid = threadIdx.x; asm volatile("" : "+v"(tid));
    const int wid = __builtin_amdgcn_readfirstlane(tid >> 6), lane = tid & 63, wr = wid >> 2, wc = wid & 3, fr = lane & 15, fq = lane >> 4;
    int K = g.K, lda = g.lda, ldb = g.ldb; asm volatile("" : "+s"(K), "+s"(lda), "+s"(ldb)); const int nt = K / BK;
    unsigned vA0[2], vA1[2], nvA0[2], nvA1[2], voffB[2]; int sR[2], sC[2];
#pragma unroll
    for (int i = 0; i < 2; ++i) { int R, C; stage_rc(tid * 16 + i * 8192, R, C); const int Rb = Epi::PERM ? ((R & ~31) + perm32(R & 31)) : R; sR[i] = R; sC[i] = C;
        vA0[i] = (unsigned)(R * lda + C) * 2u; vA1[i] = (unsigned)((R + HALF) * lda + C) * 2u; nvA0[i] = vA0[i]; nvA1[i] = vA1[i]; voffB[i] = (unsigned)(Rb * ldb + C) * 2u; }
#define PG8_GOFF(dst0, dst1, pm_) do { _Pragma("unroll") for (int _i = 0; _i < 2; ++_i) { \
        dst0[_i] = (unsigned)(g.rowtok[(pm_) * BM + sR[_i]] * lda + sC[_i]) * 2u; dst1[_i] = (unsigned)(g.rowtok[(pm_) * BM + HALF + sR[_i]] * lda + sC[_i]) * 2u; } } while (0)
    const size_t kstep = (size_t)(BK * 2);
    const size_t hstepA = (size_t)HALF * lda * 2, hstepB = (size_t)HALF * ldb * 2;
    const size_t tstepA = 2 * hstepA, tstepB = 2 * hstepB;
    const unsigned ldsw = (unsigned)wid * 1024u;
    const int aoff = lds_byte(wr * 64 + fr, fq * 8), boff = lds_byte(wc * 32 + fr, fq * 8);
#define PG8_SA(b, h) (((b) * 2 + (h)) * HTB)
#define PG8_SB(b, h) ((4 + (b) * 2 + (h)) * HTB)
#define PG8_STAGE(bufoff, gbase, voff) do { _Pragma("unroll") for (int _i = 0; _i < 2; ++_i) \
        __builtin_amdgcn_global_load_lds((const unsigned*)((const char*)(gbase) + (voff)[_i]), (LAS unsigned*)(lds + (bufoff) + ldsw + _i * 8192), 16, 0, 0); } while (0)
#define PG8_LDA(dst, b, h) do { _Pragma("unroll") for (int m = 0; m < 4; ++m) _Pragma("unroll") for (int k = 0; k < 2; ++k) dst[m][k] = *(const LAS bf16x8*)(lds + PG8_SA(b, h) + aoff + m * 2048 + k * 1024); } while (0)
#define PG8_LDB(dst, b, h) do { _Pragma("unroll") for (int n = 0; n < 2; ++n) _Pragma("unroll") for (int k = 0; k < 2; ++k) dst[n][k] = *(const LAS bf16x8*)(lds + PG8_SB(b, h) + boff + n * 2048 + k * 1024); } while (0)
#define PG8_MMA(ai, bj, At, Bt) do { __builtin_amdgcn_s_setprio(1); _Pragma("unroll") for (int m = 0; m < 4; ++m) _Pragma("unroll") for (int n = 0; n < 2; ++n) _Pragma("unroll") for (int k = 0; k < 2; ++k) \
        { if constexpr (INT8) acc[ai][bj][m][n] = __builtin_bit_cast(f32x4, __builtin_amdgcn_mfma_i32_16x16x64_i8(__builtin_bit_cast(i32x4, Bt[n][k]), __builtin_bit_cast(i32x4, At[m][k]), __builtin_bit_cast(i32x4, acc[ai][bj][m][n]), 0, 0, 0)); \
          else acc[ai][bj][m][n] = __builtin_amdgcn_mfma_f32_16x16x32_bf16(Bt[n][k], At[m][k], acc[ai][bj][m][n], 0, 0, 0); } __builtin_amdgcn_s_setprio(0); } while (0)
#define PG8_WAIT_V(n) asm volatile("s_waitcnt vmcnt(" #n ")" ::: "memory")
#define PG8_WAIT_L(n) asm volatile("s_waitcnt lgkmcnt(" #n ")" ::: "memory")
#define PG8_BAR __builtin_amdgcn_s_barrier()
#define PG8_SCHED __builtin_amdgcn_sched_barrier(0)
    LAS unsigned char* const hbase = lds + 8 * HTB; int hc = 0;
#define PG8_HDR(off, un) do { if constexpr (Epi::LDSS) E.prefetch(hbase + (off), un, wid, lane); \
        if constexpr (GATHER) { if (wid < 4) __builtin_amdgcn_global_load_lds((const unsigned*)(g.rowtok + (un).pm * BM + wid * 64 + lane), (LAS unsigned*)(hbase + (off) + 2048 + wid * 256), 4, 0, 0); } } while (0)
    Unit cur, nxt; int ui = 0;
    if (!S.next(0, cur)) return;
    f32x4 acc[2][2][4][2];
#pragma unroll
    for (int a = 0; a < 2; ++a)
#pragma unroll
        for (int b = 0; b < 2; ++b)
#pragma unroll
            for (int m = 0; m < 4; ++m)
#pragma unroll
                for (int n = 0; n < 2; ++n) acc[a][b][m][n] = (f32x4){0.f, 0.f, 0.f, 0.f};
    bf16x8 At[4][2], B0[2][2], B1[2][2];
    const char* cA = (const char*)g.A + (GATHER ? (size_t)0 : (size_t)cur.pm * tstepA); if constexpr (GATHER) PG8_GOFF(vA0, vA1, cur.pm);
    const char* cB = (const char*)g.Bt + (size_t)cur.e * g.estride * 2 + (size_t)cur.pn * tstepB;
    PG8_HDR(0, cur);
    PG8_STAGE(PG8_SB(0, 0), cB, voffB); PG8_STAGE(PG8_SB(0, 1), cB + hstepB, voffB); PG8_STAGE(PG8_SA(0, 0), cA, vA0); PG8_STAGE(PG8_SA(0, 1), cA, vA1);
    if (wr == 1) PG8_BAR;
    PG8_WAIT_V(2); PG8_BAR;
    PG8_STAGE(PG8_SB(1, 0), cB + kstep, voffB); PG8_STAGE(PG8_SA(1, 0), cA + kstep, vA0); PG8_STAGE(PG8_SB(1, 1), cB + hstepB + kstep, voffB);
    PG8_WAIT_V(6); PG8_BAR;
#if PROBE_G
    unsigned long long pg_prev = wall_clock64();
#define PG_ACC(sel) do { const unsigned long long t_ = wall_clock64(); if (PROBE_G == (sel) && PROBE_GATE && blockIdx.x == 0 && tid == 0) { volatile LAS unsigned long long* pt = (volatile LAS unsigned long long*)(lds + 143360 + 64); pt[1] += t_ - pg_prev; } pg_prev = t_; } while (0)
#else
#define PG_ACC(sel) do { } while (0)
#endif
    for (;;) {
        const bool has_next = S.next(ui + 1, nxt);
        const char* nA = has_next ? (const char*)g.A + (GATHER ? (size_t)0 : (size_t)nxt.pm * tstepA) : cA;
        const int hn = (hc == 2 * 3072) ? 0 : hc + 3072;
        if (has_next) PG8_HDR(hn, nxt);
        if constexpr (GATHER) { if (!has_next) { nvA0[0] = vA0[0]; nvA0[1] = vA0[1]; nvA1[0] = vA1[0]; nvA1[1] = vA1[1]; } } const char* nB = has_next ? (const char*)g.Bt + (size_t)nxt.e * g.estride * 2 + (size_t)nxt.pn * tstepB : cB;
        for (int t = 0; t < nt; t += 2) {
            const bool last = (t == nt - 2);
            if constexpr (GATHER) { if (last && has_next) { const LAS int* hr = (const LAS int*)(hbase + hn + 2048);
                _Pragma("unroll") for (int _i = 0; _i < 2; ++_i) { nvA0[_i] = (unsigned)(hr[sR[_i]] * lda + sC[_i]) * 2u; nvA1[_i] = (unsigned)(hr[HALF + sR[_i]] * lda + sC[_i]) * 2u; } } }
            const char* a1 = cA + (size_t)(t + 1) * kstep;
            const char* a2 = last ? nA : cA + (size_t)(t + 2) * kstep; const char* b2 = last ? nB : cB + (size_t)(t + 2) * kstep;
            const char* a3 = a2 + kstep; const char* b3 = b2 + kstep;
            unsigned sA0[2], sA1[2];
            sA0[0] = (GATHER && last) ? nvA0[0] : vA0[0]; sA0[1] = (GATHER && last) ? nvA0[1] : vA0[1]; sA1[0] = (GATHER && last) ? nvA1[0] : vA1[0]; sA1[1] = (GATHER && last) ? nvA1[1] : vA1[1];
            PG8_LDB(B0, 0, 0); PG8_LDB(B1, 0, 1); PG8_SCHED; PG8_LDA(At, 0, 0); PG8_STAGE(PG8_SA(1, 1), a1, vA1);
            PG8_WAIT_V(8); PG8_WAIT_L(0); PG8_BAR; PG8_MMA(0, 0, At, B0); PG8_MMA(0, 1, At, B1); PG8_BAR; PG8_SCHED;
            PG8_LDA(At, 0, 1); PG8_STAGE(PG8_SB(0, 0), b2, voffB); PG8_STAGE(PG8_SB(0, 1), b2 + hstepB, voffB); PG8_STAGE(PG8_SA(0, 0), a2, sA0);
            PG8_WAIT_V(8); PG8_WAIT_L(0); PG8_BAR; PG8_MMA(1, 0, At, B0); PG8_MMA(1, 1, At, B1); PG8_BAR; PG8_SCHED;
            PG8_LDB(B0, 1, 0); PG8_LDB(B1, 1, 1); PG8_SCHED; PG8_LDA(At, 1, 0); PG8_STAGE(PG8_SA(0, 1), a2, sA1);
            PG8_WAIT_V(8); PG8_WAIT_L(0); PG8_BAR; PG8_MMA(0, 0, At, B0); PG8_MMA(0, 1, At, B1); PG8_BAR; PG8_SCHED;
            PG8_LDA(At, 1, 1); PG8_STAGE(PG8_SB(1, 0), b3, voffB); PG8_STAGE(PG8_SB(1, 1), b3 + hstepB, voffB); PG8_STAGE(PG8_SA(1, 0), a3, sA0);
            PG8_WAIT_V(8); PG8_WAIT_L(0); PG8_BAR; PG8_MMA(1, 0, At, B0); PG8_MMA(1, 1, At, B1); PG8_BAR; PG8_SCHED;
        }
        PG_ACC(2);
        if constexpr (ALIGN_EPI) { if (wr == 0) PG8_BAR; }
        if constexpr (Epi::LDSS) E(acc, cur, wr, wc, fr, fq, (const LAS float*)(hbase + hc)); else E(acc, cur, wr, wc, fr, fq);
        PG_ACC(1);
        if (!has_next) break;
#pragma unroll
        for (int a = 0; a < 2; ++a)
#pragma unroll
            for (int b = 0; b < 2; ++b)
#pragma unroll
                for (int m = 0; m < 4; ++m)
#pragma unroll
                    for (int n = 0; n < 2; ++n) acc[a][b][m][n] = (f32x4){0.f, 0.f, 0.f, 0.f};
        cur = nxt; cA = nA; cB = nB; ++ui; hc = hn;
        if constexpr (GATHER) { vA0[0] = nvA0[0]; vA0[1] = nvA0[1]; vA1[0] = nvA1[0]; vA1[1] = nvA1[1]; }
        if constexpr (ALIGN_EPI) { if (wr == 1) PG8_BAR; }
    }
    PG8_WAIT_V(0);
    if constexpr (!ALIGN_EPI) { if (wr == 0) PG8_BAR; }
    PG8_BAR;
#undef PG_ACC
#undef PG8_HDR
#undef PG8_GOFF
#undef PG8_SA
#undef PG8_SB
#undef PG8_STAGE
#undef PG8_LDA
#undef PG8_LDB
#undef PG8_MMA
#undef PG8_WAIT_V
#undef PG8_WAIT_L
#undef PG8_BAR
#undef PG8_SCHED
}

template <int MODE> struct EpiBf16 {
    static constexpr bool PERM = true, LDSS = false;
    bf16_t* O; int ldc; const float* rope;
    __device__ __forceinline__ void operator()(const f32x4 (&acc)[2][2][4][2], const Unit& u, int wr, int wc, int fr, int fq) const {
        const int row0 = u.pm * BM + wr * 64 + fr;
        const float* t16 = rope; const float* t8 = rope + 2048 * 16; const float* t32 = rope + 2048 * 24;
#pragma unroll
        for (int bj = 0; bj < 2; ++bj) {
            const int gc = u.pn * BM + bj * HALF + wc * 32 + 8 * fq;
            const float* tb = nullptr; int tstride = 0, sinoff = 0;
            if (MODE == 1) {
                const bool r64 = (gc < C_VA) || (gc >= C_QB && gc < C_VB);
                if (r64 && (gc & 63) < 16) { tb = t16 + ((gc & 63) >> 3) * 4; tstride = 16; sinoff = 8; }
                else if (gc >= C_QI && gc < C_WI && (gc & 31) == 0) { tb = t8; tstride = 8; sinoff = 4; }
            } else if (MODE == 2) {
                if (gc >= C_KR && gc < C_KR + 32) { tb = t32 + ((gc - C_KR) >> 3) * 4; tstride = 32; sinoff = 16; }
            } else if (MODE == 3) {
                if (gc >= 512) { tb = t32 + ((gc & 31) >> 3) * 4; tstride = 32; sinoff = 16; }
            }
#pragma unroll
            for (int ai = 0; ai < 2; ++ai)
#pragma unroll
                for (int m = 0; m < 4; ++m) {
                    const int row = row0 + ai * HALF + m * 16;
                    f32x4 v0 = acc[ai][bj][m][0], v1 = acc[ai][bj][m][1];
                    if (MODE != 0) { if (tb) { const float* tp = tb + (size_t)(row & (SEQ - 1)) * tstride; const f32x4 c = *(const f32x4*)tp, s = *(const f32x4*)(tp + sinoff);
                        const f32x4 a = v0 * c - v1 * s, b = v0 * s + v1 * c; v0 = a; v1 = b; } }
                    u32x4 w; w.x = cvtpk(v0[0], v0[1]); w.y = cvtpk(v0[2], v0[3]); w.z = cvtpk(v1[0], v1[1]); w.w = cvtpk(v1[2], v1[3]);
                    *(u32x4*)(O + (size_t)row * ldc + gc) = w;
                }
        }
    }
};
template <int MODE> struct EpiBf16Q {
    static constexpr bool PERM = true, LDSS = true;
    bf16_t* O; int ldc; const float* rope; const float* sa; const float* wmax;
    __device__ __forceinline__ void prefetch(LAS unsigned char* hb, const Unit& u, int wid, int lane) const {
        const float* src = (wid < 4) ? sa + u.pm * BM + wid * 64 + lane : wmax + u.pn * BM + (wid - 4) * 64 + lane;
        __builtin_amdgcn_global_load_lds((const unsigned*)src, (LAS unsigned*)(hb + wid * 256), 4, 0, 0);
    }
    __device__ __forceinline__ void operator()(const f32x4 (&acc)[2][2][4][2], const Unit& u, int wr, int wc, int fr, int fq, const LAS float* hs) const {
        const int row0 = u.pm * BM + wr * 64 + fr;
        const float* t16 = rope; const float* t8 = rope + 2048 * 16; const float* t32 = rope + 2048 * 24;
#pragma unroll
        for (int bj = 0; bj < 2; ++bj) {
            const int gc = u.pn * BM + bj * HALF + wc * 32 + 8 * fq;
            const float* tb = nullptr; int tstride = 0, sinoff = 0;
            if (MODE == 1) {
                const bool r64 = (gc < C_VA) || (gc >= C_QB && gc < C_VB);
                if (r64 && (gc & 63) < 16) { tb = t16 + ((gc & 63) >> 3) * 4; tstride = 16; sinoff = 8; }
                else if (gc >= C_QI && gc < C_WI && (gc & 31) == 0) { tb = t8; tstride = 8; sinoff = 4; }
            } else if (MODE == 2) {
                if (gc >= C_KR && gc < C_KR + 32) { tb = t32 + ((gc - C_KR) >> 3) * 4; tstride = 32; sinoff = 16; }
            } else if (MODE == 3) {
                if (gc >= 512) { tb = t32 + ((gc & 31) >> 3) * 4; tstride = 32; sinoff = 16; }
            }
            const f32x4 ws0 = *(const LAS f32x4*)(hs + 256 + bj * HALF + wc * 32 + 8 * fq) * (1.0f / 127.0f), ws1 = *(const LAS f32x4*)(hs + 256 + bj * HALF + wc * 32 + 8 * fq + 4) * (1.0f / 127.0f);
#pragma unroll
            for (int ai = 0; ai < 2; ++ai)
#pragma unroll
                for (int m = 0; m < 4; ++m) {
                    const int row = row0 + ai * HALF + m * 16;
                    f32x4 v0, v1; { const i32x4 i0 = __builtin_bit_cast(i32x4, acc[ai][bj][m][0]), i1 = __builtin_bit_cast(i32x4, acc[ai][bj][m][1]); const float sr = hs[wr * 64 + fr + ai * HALF + m * 16];
                        v0 = (f32x4){(float)i0[0], (float)i0[1], (float)i0[2], (float)i0[3]} * (ws0 * sr); v1 = (f32x4){(float)i1[0], (float)i1[1], (float)i1[2], (float)i1[3]} * (ws1 * sr); }
                    if (MODE != 0) { if (tb) { const float* tp = tb + (size_t)(row & (SEQ - 1)) * tstride; const f32x4 c = *(const f32x4*)tp, s = *(const f32x4*)(tp + sinoff);
                        const f32x4 a = v0 * c - v1 * s, b = v0 * s + v1 * c; v0 = a; v1 = b; } }
                    u32x4 w; w.x = cvtpk(v0[0], v0[1]); w.y = cvtpk(v0[2], v0[3]); w.z = cvtpk(v1[0], v1[1]); w.w = cvtpk(v1[2], v1[3]);
                    *(u32x4*)(O + (size_t)row * ldc + gc) = w;
                }
        }
    }
};
template <bool BF32> struct EpiRes {
    static constexpr bool PERM = true, LDSS = false;
    bf16_t* O; const void* base;
    __device__ __forceinline__ void operator()(const f32x4 (&acc)[2][2][4][2], const Unit& u, int wr, int wc, int fr, int fq) const {
        const int row0 = u.pm * BM + wr * 64 + fr;
#pragma unroll
        for (int bj = 0; bj < 2; ++bj) {
            const int gc = u.pn * BM + bj * HALF + wc * 32 + 8 * fq;
#pragma unroll
            for (int ai = 0; ai < 2; ++ai)
#pragma unroll
                for (int m = 0; m < 4; ++m) {
                    const size_t off = (size_t)(row0 + ai * HALF + m * 16) * DM + gc;
                    f32x4 v0 = acc[ai][bj][m][0], v1 = acc[ai][bj][m][1];
                    if (BF32) { v0 += *(const f32x4*)((const float*)base + off); v1 += *(const f32x4*)((const float*)base + off + 4); }
                    else { const u32x4 b = *(const u32x4*)((const bf16_t*)base + off); v0 += (f32x4){bflo(b.x), bfhi(b.x), bflo(b.y), bfhi(b.y)}; v1 += (f32x4){bflo(b.z), bfhi(b.z), bflo(b.w), bfhi(b.w)}; }
                    u32x4 w; w.x = cvtpk(v0[0], v0[1]); w.y = cvtpk(v0[2], v0[3]); w.z = cvtpk(v1[0], v1[1]); w.w = cvtpk(v1[2], v1[3]);
                    *(u32x4*)(O + off) = w;
                }
        }
    }
};
struct EpiF32 {
    static constexpr bool PERM = false, LDSS = false;
    float* C; const float* base; int ldc; int row_sub;
    __device__ __forceinline__ void operator()(const f32x4 (&acc)[2][2][4][2], const Unit& u, int wr, int wc, int fr, int fq) const {
        const int row0 = u.pm * BM - row_sub + wr * 64 + fr, col0 = u.pn * BM + wc * 32 + 4 * fq;
#pragma unroll
        for (int ai = 0; ai < 2; ++ai)
#pragma unroll
            for (int m = 0; m < 4; ++m) { const size_t off = (size_t)(row0 + ai * HALF + m * 16) * ldc + col0;
#pragma unroll
                for (int bj = 0; bj < 2; ++bj)
#pragma unroll
                    for (int n = 0; n < 2; ++n) { f32x4 v = acc[ai][bj][m][n]; if (base) v += *(const f32x4*)(base + off + bj * HALF + n * 16); *(f32x4*)(C + off + bj * HALF + n * 16) = v; } }
    }
};
struct EpiSwiGLU {
    static constexpr bool PERM = true, LDSS = false;
    bf16_t* O;
    __device__ __forceinline__ void operator()(const f32x4 (&acc)[2][2][4][2], const Unit& u, int wr, int wc, int fr, int fq) const {
        const int row0 = u.pm * BM + wr * 64 + fr, col0 = u.pn * HALF + wc * 32 + 8 * fq;
#pragma unroll
        for (int ai = 0; ai < 2; ++ai)
#pragma unroll
            for (int m = 0; m < 4; ++m) {
                float r[8];
#pragma unroll
                for (int n = 0; n < 2; ++n)
#pragma unroll
                    for (int j = 0; j < 4; ++j) { const float gv = acc[ai][0][m][n][j], uv = acc[ai][1][m][n][j]; r[n * 4 + j] = gv * __builtin_amdgcn_rcpf(1.0f + __expf(-gv)) * uv; }
                u32x4 w; w.x = cvtpk(r[0], r[1]); w.y = cvtpk(r[2], r[3]); w.z = cvtpk(r[4], r[5]); w.w = cvtpk(r[6], r[7]);
                *(u32x4*)(O + (size_t)(row0 + ai * HALF + m * 16) * DFF + col0) = w;
            }
    }
};
struct EpiSwiGLU8 {
    static constexpr bool PERM = true, LDSS = true;
    bf16_t* O; const float* sa; const float* cmax; size_t cstride;
    __device__ __forceinline__ void prefetch(LAS unsigned char* hb, const Unit& u, int wid, int lane) const {
        const float* src = (wid < 4) ? sa + u.pm * BM + wid * 64 + lane : cmax + (size_t)u.e * cstride + u.pn * BM + (wid - 4) * 64 + lane;
        __builtin_amdgcn_global_load_lds((const unsigned*)src, (LAS unsigned*)(hb + wid * 256), 4, 0, 0);
    }
    __device__ __forceinline__ void operator()(const f32x4 (&acc)[2][2][4][2], const Unit& u, int wr, int wc, int fr, int fq, const LAS float* hs) const {
        const int row0 = u.pm * BM + wr * 64 + fr, col0 = u.pn * HALF + wc * 32 + 8 * fq;
        const LAS float* cm = hs + 256 + wc * 32 + 8 * fq;
        const f32x4 sg0 = *(const LAS f32x4*)cm * (1.0f / 127.0f), sg1 = *(const LAS f32x4*)(cm + 4) * (1.0f / 127.0f), su0 = *(const LAS f32x4*)(cm + HALF) * (1.0f / 127.0f), su1 = *(const LAS f32x4*)(cm + HALF + 4) * (1.0f / 127.0f);
#pragma unroll
        for (int ai = 0; ai < 2; ++ai)
#pragma unroll
            for (int m = 0; m < 4; ++m) {
                const int row = row0 + ai * HALF + m * 16; const float sr = hs[wr * 64 + fr + ai * HALF + m * 16];
                float r[8];
#pragma unroll
                for (int n = 0; n < 2; ++n)
#pragma unroll
                    for (int j = 0; j < 4; ++j) { const i32x4 gi = __builtin_bit_cast(i32x4, acc[ai][0][m][n]), ui = __builtin_bit_cast(i32x4, acc[ai][1][m][n]);
                        const float gv = (float)gi[j] * sr * (n ? sg1[j] : sg0[j]), uv = (float)ui[j] * sr * (n ? su1[j] : su0[j]); r[n * 4 + j] = gv * __builtin_amdgcn_rcpf(1.0f + __expf(-gv)) * uv; }
                u32x4 w; w.x = cvtpk(r[0], r[1]); w.y = cvtpk(r[2], r[3]); w.z = cvtpk(r[4], r[5]); w.w = cvtpk(r[6], r[7]);
                *(u32x4*)(O + (size_t)row * DFF + col0) = w;
            }
    }
};
}

#define XB_TMO      128
#define XB_XCNT(j)  (256  + 64 * (j))
#define XB_XSUB(j)  (1280 + 64 * (j))
#define XB_XGEN(j)  (2304 + 64 * (j))
#define XB_TOP      3328
#define XB_TOPGEN   3392
#define XCD_BAR_WORDS 3456
#define XB_SPIN_CAP (1u << 22)
DI unsigned xb_ld(unsigned* p)              { return __hip_atomic_load(p, __ATOMIC_RELAXED, __HIP_MEMORY_SCOPE_AGENT); }
DI unsigned xb_add(unsigned* p, unsigned v) { return __hip_atomic_fetch_add(p, v, __ATOMIC_RELAXED, __HIP_MEMORY_SCOPE_AGENT); }
DI unsigned xb_xcc_id() { return (unsigned)__builtin_amdgcn_s_getreg((3 << 11) | 20) & 0xFu; }
#define XB_SPIN(cond, bar) do { unsigned _sp = 0; while (cond) { __builtin_amdgcn_s_sleep(1); \
    if ((++_sp & 255u) == 0u) { if (xb_ld(&(bar)[XB_TMO])) break; if (_sp > XB_SPIN_CAP) { atomicAdd(&(bar)[XB_TMO], 1u); break; } } } } while (0)
struct XcdBarrier { unsigned* bar; unsigned x; volatile LAS unsigned* st; };
DI XcdBarrier xcd_barrier_post(unsigned* bar, volatile LAS unsigned* st) {
    XcdBarrier b; b.bar = bar; b.x = xb_xcc_id(); b.st = st;
    if (threadIdx.x == 0) (void)xb_add(&bar[XB_XCNT(b.x)], 1u);
    return b;
}
DI void xcd_barrier_complete(unsigned* bar, unsigned x, unsigned& nloc, unsigned& nx) {
    const unsigned G = gridDim.x * gridDim.y * gridDim.z;
    unsigned sum, cnt, mine, sp = 0u;
    for (;;) {
        sum = 0u; cnt = 0u; mine = 0u;
#pragma unroll
        for (unsigned j = 0; j < 16; ++j) { const unsigned c = xb_ld(&bar[XB_XCNT(j)]); sum += c; cnt += (c > 0u) ? 1u : 0u; mine = (j == x) ? c : mine; }
        if (sum == G) break;
        __builtin_amdgcn_s_sleep(1);
        if ((++sp & 255u) == 0u) { if (xb_ld(&bar[XB_TMO])) break; if (sp > XB_SPIN_CAP) { atomicAdd(&bar[XB_TMO], 1u); break; } }
    }
    nloc = mine > 0u ? mine : 1u; nx = cnt > 0u ? cnt : 1u;
}
DI void xcd_barrier(const XcdBarrier& b) {
    asm volatile("s_waitcnt vmcnt(0)" ::: "memory");
    __syncthreads();
    if (threadIdx.x == 0) {
        unsigned* bar = b.bar;
        __builtin_amdgcn_s_waitcnt(0);
        unsigned nloc = b.st[0], nx = b.st[1];
        if (nloc == 0u) { xcd_barrier_complete(bar, b.x, nloc, nx); b.st[0] = nloc; b.st[1] = nx; }
        const unsigned old = xb_add(&bar[XB_XSUB(b.x)], 1u);
        const unsigned gen = old / nloc;
        if (old + 1u == (gen + 1u) * nloc) {
            __builtin_amdgcn_fence(__ATOMIC_RELEASE, "agent");
            asm volatile("s_waitcnt vmcnt(0)" ::: "memory");
            const unsigned og = xb_add(&bar[XB_TOP], 1u);
            const unsigned tg = og / nx;
            if (og + 1u == (tg + 1u) * nx) xb_add(&bar[XB_TOPGEN], 1u);
            else XB_SPIN(xb_ld(&bar[XB_TOPGEN]) == tg, bar);
            __builtin_amdgcn_fence(__ATOMIC_ACQUIRE, "agent");
            xb_add(&bar[XB_XGEN(b.x)], 1u);
            asm volatile("s_waitcnt vmcnt(0)" ::: "memory");
        } else {
            XB_SPIN(xb_ld(&bar[XB_XGEN(b.x)]) == gen, bar);
            __builtin_amdgcn_fence(__ATOMIC_ACQUIRE, "agent");
            asm volatile("s_waitcnt vmcnt(0)" ::: "memory");
        }
    }
    __syncthreads();
}

struct Args { const float* in[28]; float* out; unsigned char* ws; int ph_lo, ph_hi; };
struct Frame {
    LAS unsigned char* lds;
    unsigned char* ws;
    const float* const* in;
    int tid, lane, wave, vcu, G, gw, NGW;
    DI const float* gin(int k) const { GAS const float* p = (GAS const float*)in[k]; asm volatile("" : "+s"(p)); return (const float*)p; }
};

DI int pd64(int d) { if (d < 16) { const int i = d & 7, part = d >> 3; return (i >> 2) * 8 + part * 4 + (i & 3); } return d; }
DI int pd32m(int d) { const int i = d & 15, part = d >> 4; return (i >> 2) * 8 + part * 4 + (i & 3); }
struct RmPlain { int off; DI int operator()(int n) const { return off + n; } };
struct RmEvenIn { DI int operator()(int n) const {
    if (n < 512) return C_QA + (n & ~63) + pd64(n & 63);
    if (n < 640) { const int m = n - 512; return C_KA + (m & ~63) + pd64(m & 63); }
    if (n < 768) return C_VA + (n - 640);
    if (n < 1024) return C_QI + (n - 768);
    if (n < 1056) return C_KI + (n - 1024);
    if (n < 1064) return C_WI + (n - 1056);
    if (n < 1576) { const int m = n - 1064; return C_QB + (m & ~63) + pd64(m & 63); }
    if (n < 2088) { const int m = n - 1576; return C_KB + (m & ~63) + pd64(m & 63); }
    return C_VB + (n - 2088); } };
struct RmGateUp { int which; DI int operator()(int n) const { return (n >> 7) * 256 + which * 128 + (n & 127); } };
struct RmOddIn { DI int operator()(int n) const {
    if (n < 256) return C_CQ + n;
    if (n < 384) return C_CKV + (n - 256);
    if (n < 416) return C_KR + pd32m(n - 384);
    if (n < 928) return C_XR + (n - 416);
    return C_GR + (n - 928); } };
struct RmUq { DI int operator()(int n) const { const int h = n / 96, d = n - h * 96; return d < 64 ? h * 64 + d : 512 + h * 32 + pd32m(d - 64); } };

struct CvtDesc { const float* W; bf16_t* WT; int N, ldk, kb, nb, kind; };
DI int cvt_row(int kind, int n) {
    if (kind == 0) return n;
    if (kind == 1) return RmEvenIn{}(n);
    if (kind == 2) return RmGateUp{0}(n);
    if (kind == 3) return RmGateUp{1}(n);
    if (kind == 4) return RmOddIn{}(n);
    return RmUq{}(n);
}
DI void cvt_load(const CvtDesc& d, int lane, f32x4 (&v)[8]) {
    const int kg = lane >> 3, n4 = lane & 7, k0 = d.kb * 64 + kg * 8, n = d.nb * 32 + n4 * 4;
    if (n < d.N) {
#pragma unroll
        for (int i = 0; i < 8; ++i) v[i] = __builtin_nontemporal_load((const f32x4*)(d.W + (size_t)(k0 + i) * d.N + n));
    }
}
DI void cvt_store(const CvtDesc& d, int lane, const f32x4 (&v)[8]) {
    const int kg = lane >> 3, n4 = lane & 7, k0 = d.kb * 64 + kg * 8, n = d.nb * 32 + n4 * 4;
    if (n < d.N) {
#pragma unroll
        for (int q = 0; q < 4; ++q) { u32x4 w; w.x = cvtpk(v[0][q], v[1][q]); w.y = cvtpk(v[2][q], v[3][q]); w.z = cvtpk(v[4][q], v[5][q]); w.w = cvtpk(v[6][q], v[7][q]);
            *(u32x4*)(d.WT + (size_t)cvt_row(d.kind, n + q) * d.ldk + k0) = w; }
    }
}
constexpr int CE_IN = 16 * 82, CE_OUT = 16 * 32, CE_G = 16 * 112, CE_D = 56 * 32, CE_NIT = CE_IN + CE_OUT + 2 * CE_G + CE_D;
DI CvtDesc cvt_even_desc(Frame& F, int li, int it) {
    bf16_t* we = (bf16_t*)(F.ws + WS_WE);
    int r = it;
    if (r < CE_IN) return CvtDesc{F.gin(2) + (size_t)li * 1024 * EV_N, we + WE_IN / 2, EV_N, 1024, r / 82, r % 82, 1}; r -= CE_IN;
    if (r < CE_OUT) return CvtDesc{F.gin(3) + (size_t)li * 1024 * 1024, we + WE_OUT / 2, 1024, 1024, r / 32, r % 32, 0}; r -= CE_OUT;
    if (r < CE_G) return CvtDesc{F.gin(5) + (size_t)li * 1024 * DFF, we + WE_GU / 2, DFF, 1024, r / 112, r % 112, 2}; r -= CE_G;
    if (r < CE_G) return CvtDesc{F.gin(6) + (size_t)li * 1024 * DFF, we + WE_GU / 2, DFF, 1024, r / 112, r % 112, 3}; r -= CE_G;
    return CvtDesc{F.gin(7) + (size_t)li * DFF * 1024, we + WE_DN / 2, 1024, DFF, r / 32, r % 32, 0};
}
DI void cvt_even_zero(Frame& F) {
    bf16_t* d_in = (bf16_t*)(F.ws + WS_WE) + WE_IN / 2;
    for (int i = F.gw * 64 + F.lane; i < (EV_NP - EV_N) * 1024 / 8; i += F.NGW * 64) *(u32x4*)(d_in + (size_t)EV_N * 1024 + (size_t)i * 8) = (u32x4){0u, 0u, 0u, 0u};
}
constexpr int CO_IN = 16 * 45, CO_UQ = 4 * 24, CO_UKV = 2 * 32, CO_OUT = 16 * 32, CO_RG = 32, CO_G = 16 * 112, CO_D = 56 * 32, CO_NIT = CO_IN + CO_UQ + CO_UKV + CO_OUT + CO_RG + NEXP * (2 * CO_G + CO_D);
DI CvtDesc cvt_odd_desc(Frame& F, int li, int it) {
    bf16_t* wo = (bf16_t*)(F.ws + WS_WO);
    int r = it;
    if (r < CO_IN) return CvtDesc{F.gin(9) + (size_t)li * 1024 * OD_N, wo + WO_IN / 2, OD_N, 1024, r / 45, r % 45, 4}; r -= CO_IN;
    if (r < CO_UQ) return CvtDesc{F.gin(11) + (size_t)li * 256 * 768, wo + WO_UQ / 2, 768, 256, r / 24, r % 24, 5}; r -= CO_UQ;
    if (r < CO_UKV) return CvtDesc{F.gin(13) + (size_t)li * 128 * 1024, wo + WO_UKV / 2, 1024, 256, r / 32, r % 32, 0}; r -= CO_UKV;
    if (r < CO_OUT) return CvtDesc{F.gin(21) + (size_t)li * 1024 * 1024, wo + WO_OUT / 2, 1024, 1024, r / 32, r % 32, 0}; r -= CO_OUT;
    if (r < CO_RG) { const int mat = r >> 1, nb = r & 1; const float* src = (mat < 8 ? F.gin(16) + (size_t)li * 8 * 4096 + mat * 4096 : F.gin(18) + (size_t)li * 8 * 4096 + (mat - 8) * 4096); return CvtDesc{src, wo + WO_RG / 2 + mat * 4096, 64, 64, 0, nb, 0}; } r -= CO_RG;
    const int e = r / (2 * CO_G + CO_D); int q = r - e * (2 * CO_G + CO_D);
    if (q < CO_G) return CvtDesc{F.gin(24) + ((size_t)li * NEXP + e) * 1024 * DFF, wo + WO_MGU / 2 + (size_t)e * 7168 * 1024, DFF, 1024, q / 112, q % 112, 2}; q -= CO_G;
    if (q < CO_G) return CvtDesc{F.gin(25) + ((size_t)li * NEXP + e) * 1024 * DFF, wo + WO_MGU / 2 + (size_t)e * 7168 * 1024, DFF, 1024, q / 112, q % 112, 3}; q -= CO_G;
    return CvtDesc{F.gin(26) + ((size_t)li * NEXP + e) * DFF * 1024, wo + WO_MDN / 2 + (size_t)e * 1024 * DFF, 1024, DFF, q / 32, q % 32, 0};
}
DI void cvt_odd_zero(Frame& F) {
    bf16_t* wo = (bf16_t*)(F.ws + WS_WO); bf16_t* d_in = wo + WO_IN / 2; bf16_t* d_ukv = wo + WO_UKV / 2;
    for (int i = F.gw * 64 + F.lane; i < 96 * 1024 / 8; i += F.NGW * 64) *(u32x4*)(d_in + (size_t)416 * 1024 + (size_t)i * 8) = (u32x4){0u, 0u, 0u, 0u};
    for (int i = F.gw * 64 + F.lane; i < 1024 * 16; i += F.NGW * 64) *(u32x4*)(d_ukv + (size_t)(i >> 4) * 256 + 128 + (i & 15) * 8) = (u32x4){0u, 0u, 0u, 0u};
}
struct CvtRider { int it, end, li; };
constexpr int CO_RIDE = 20 * 2048, CO_R0 = CO_NIT - CO_RIDE;
template <bool ODD> DI void phase_cvt(Frame& F, int li, int it_begin, int NIT, bool zero_fill) {
    int it = it_begin + F.gw;
    if (it < NIT) {
        CvtDesc d0 = ODD ? cvt_odd_desc(F, li, it) : cvt_even_desc(F, li, it), d1 = d0; f32x4 a[8], b[8];
        cvt_load(d0, F.lane, a);
        for (;;) {
            const int it1 = it + F.NGW; const bool h1 = it1 < NIT;
            if (h1) { d1 = ODD ? cvt_odd_desc(F, li, it1) : cvt_even_desc(F, li, it1); cvt_load(d1, F.lane, b); }
            cvt_store(d0, F.lane, a);
            if (!h1) break;
            const int it2 = it1 + F.NGW; const bool h2 = it2 < NIT;
            if (h2) { d0 = ODD ? cvt_odd_desc(F, li, it2) : cvt_even_desc(F, li, it2); cvt_load(d0, F.lane, a); }
            cvt_store(d1, F.lane, b);
            if (!h2) break;
            it = it2;
        }
    }
    if (zero_fill) { if (ODD) cvt_odd_zero(F); else cvt_even_zero(F); }
}
DI void phase_rope_tables(Frame& F) {
    float* t16 = (float*)(F.ws + WS_ROPE); float* t8 = t16 + 2048 * 16; float* t32 = t16 + 2048 * 24;
    const double lnth = 13.122363377404328;
    for (int i = F.gw * 64 + F.lane; i < 2048 * 28; i += F.NGW * 64) {
        const int pos = i / 28, j = i % 28; int rot, f; float* dst;
        if (j < 8) { rot = 16; f = j; dst = t16 + pos * 16 + f; } else if (j < 12) { rot = 8; f = j - 8; dst = t8 + pos * 8 + f; } else { rot = 32; f = j - 12; dst = t32 + pos * 32 + f; }
        const float invf = (float)exp(-(double)(2 * f) / (double)rot * lnth);
        const float ang = (float)pos * invf;
        dst[0] = (float)cos((double)ang); dst[rot / 2] = (float)sin((double)ang);
    }
}

template <int MODE, bool Q8 = false> DI void phase_norm(Frame& F, const float* src, const float* gain, bf16_t* H, float* outf) {
    float* sa = (float*)(F.ws + WS_MISC + MISC_RT + RT_SA);
    bf16_t* X = (bf16_t*)(F.ws + WS_X);
    const float* Y = (const float*)(F.ws + WS_PY + PY_Y);
    const int* dest = (const int*)(F.ws + WS_MISC + MISC_RT); const float* rgate = (const float*)(F.ws + WS_MISC + MISC_RT + 256 * 1024);
    f32x4 g[4];
#pragma unroll
    for (int j = 0; j < 4; ++j) g[j] = *(const f32x4*)(gain + 4 * (F.lane + 64 * j));
    for (int row = F.gw; row < MTOK; row += F.NGW) {
        f32x4 v[4]; float ss = 0.f;
#pragma unroll
        for (int j = 0; j < 4; ++j) {
            if (MODE == 0) v[j] = *(const f32x4*)(src + (size_t)row * DM + 4 * (F.lane + 64 * j));
            else { const u32x2 w = *(const u32x2*)(X + (size_t)row * DM + 4 * (F.lane + 64 * j)); v[j] = (f32x4){bflo(w.x), bfhi(w.x), bflo(w.y), bfhi(w.y)}; } }
        if (MODE != 0) {
            const int d0 = dest[row * 2], d1 = dest[row * 2 + 1]; const float g0 = rgate[row * 2], g1 = rgate[row * 2 + 1];
            const float* YP = (const float*)(F.ws + WS_PY + PY_XR);
#pragma unroll
            for (int k = 0; k < 2; ++k) { const int d = k ? d1 : d0; const float gk = k ? g1 : g0;
                if (d < 32768) { const bf16_t* y = (const bf16_t*)Y + (size_t)d * DM;
#pragma unroll
                    for (int j = 0; j < 4; ++j) { const u32x2 w = *(const u32x2*)(y + 4 * (F.lane + 64 * j)); v[j] = v[j] + (f32x4){bflo(w.x), bfhi(w.x), bflo(w.y), bfhi(w.y)} * gk; } }
                else { const float* y = YP + (size_t)(d - 32768) * DM;
#pragma unroll
                    for (int j = 0; j < 4; ++j) { f32x4 a = *(const f32x4*)(y + 4 * (F.lane + 64 * j));
#pragma unroll
                        for (int sl = 1; sl < 7; ++sl) a += *(const f32x4*)(y + (size_t)sl * 2048 * DM + 4 * (F.lane + 64 * j));
                        v[j] = v[j] + a * gk; } } }
            if (MODE == 1) {
#pragma unroll
                for (int j = 0; j < 4; ++j) { u32x2 w; w.x = cvtpk(v[j][0], v[j][1]); w.y = cvtpk(v[j][2], v[j][3]); *(u32x2*)(X + (size_t)row * DM + 4 * (F.lane + 64 * j)) = w; }
            }
        }
#pragma unroll
        for (int j = 0; j < 4; ++j) ss += (v[j][0] * v[j][0] + v[j][1] * v[j][1]) + (v[j][2] * v[j][2] + v[j][3] * v[j][3]);
        const float rstd = 1.0f / sqrtf(wave_sum(ss) * (1.0f / DM) + 1e-6f);
#pragma unroll
        for (int j = 0; j < 4; ++j) { const f32x4 y = v[j] * rstd * g[j]; v[j] = y;
            if (MODE == 2) *(f32x4*)(outf + (size_t)row * DM + 4 * (F.lane + 64 * j)) = y;
            else if (!Q8) { u32x2 w; w.x = cvtpk(y[0], y[1]); w.y = cvtpk(y[2], y[3]); *(u32x2*)(H + (size_t)row * DM + 4 * (F.lane + 64 * j)) = w; } }
        if (Q8 && MODE != 2) { float mx = 0.f;
#pragma unroll
            for (int j = 0; j < 4; ++j) mx = fmaxf(mx, fmaxf(fmaxf(fabsf(v[j][0]), fabsf(v[j][1])), fmaxf(fabsf(v[j][2]), fabsf(v[j][3]))));
            mx = wave_max(mx); const float sc = mx > 0.f ? mx * (1.0f / 127.0f) : 1.0f, inv = 1.0f / sc;
            if (F.lane == 0) sa[row] = sc;
#pragma unroll
            for (int j = 0; j < 4; ++j) { const int q0 = (int)rintf(v[j][0] * inv), q1 = (int)rintf(v[j][1] * inv), q2 = (int)rintf(v[j][2] * inv), q3 = (int)rintf(v[j][3] * inv);
                *(unsigned*)((signed char*)H + (size_t)row * DM + 4 * (F.lane + 64 * j)) = (unsigned)(q0 & 255) | ((unsigned)(q1 & 255) << 8) | ((unsigned)(q2 & 255) << 16) | ((unsigned)(q3 & 255) << 24); } }
    }
}
DI void phase_norm8(Frame& F, const bf16_t* X, const float* gain, signed char* H8, float* sa) {
    f32x4 g[4];
#pragma unroll
    for (int j = 0; j < 4; ++j) g[j] = *(const f32x4*)(gain + 4 * (F.lane + 64 * j));
    for (int row = F.gw; row < MTOK; row += F.NGW) {
        f32x4 v[4]; float ss = 0.f;
#pragma unroll
        for (int j = 0; j < 4; ++j) { const u32x2 w = *(const u32x2*)(X + (size_t)row * DM + 4 * (F.lane + 64 * j)); v[j] = (f32x4){bflo(w.x), bfhi(w.x), bflo(w.y), bfhi(w.y)}; ss += (v[j][0] * v[j][0] + v[j][1] * v[j][1]) + (v[j][2] * v[j][2] + v[j][3] * v[j][3]); }
        const float rstd = 1.0f / sqrtf(wave_sum(ss) * (1.0f / DM) + 1e-6f);
        float mx = 0.f;
#pragma unroll
        for (int j = 0; j < 4; ++j) { v[j] = v[j] * rstd * g[j]; mx = fmaxf(mx, fmaxf(fmaxf(fabsf(v[j][0]), fabsf(v[j][1])), fmaxf(fabsf(v[j][2]), fabsf(v[j][3])))); }
        mx = wave_max(mx); const float sc = mx > 0.f ? mx * (1.0f / 127.0f) : 1.0f, inv = 1.0f / sc;
        if (F.lane == 0) sa[row] = sc;
#pragma unroll
        for (int j = 0; j < 4; ++j) { const int q0 = (int)rintf(v[j][0] * inv), q1 = (int)rintf(v[j][1] * inv), q2 = (int)rintf(v[j][2] * inv), q3 = (int)rintf(v[j][3] * inv);
            *(unsigned*)(H8 + (size_t)row * DM + 4 * (F.lane + 64 * j)) = (unsigned)(q0 & 255) | ((unsigned)(q1 & 255) << 8) | ((unsigned)(q2 & 255) << 16) | ((unsigned)(q3 & 255) << 24); }
    }
}
DI void phase_requant(Frame& F, const bf16_t* Wb, float* wmax, signed char* W8, int nrows) {
    for (int row = F.gw; row < nrows; row += F.NGW) {
        const u32x4 a = *(const u32x4*)(Wb + (size_t)row * 1024 + 16 * F.lane), b = *(const u32x4*)(Wb + (size_t)row * 1024 + 16 * F.lane + 8);
        const unsigned wsrc[8] = {a.x, a.y, a.z, a.w, b.x, b.y, b.z, b.w}; float mx = 0.f;
#pragma unroll
        for (int i = 0; i < 8; ++i) mx = fmaxf(mx, fmaxf(fabsf(bflo(wsrc[i])), fabsf(bfhi(wsrc[i]))));
        mx = wave_max(mx); const float inv = mx > 0.f ? 127.0f / mx : 0.f;
        if (F.lane == 0) wmax[row] = mx;
        unsigned out[4];
#pragma unroll
        for (int i = 0; i < 4; ++i) { int q[4];
#pragma unroll
            for (int k = 0; k < 2; ++k) { const unsigned w = wsrc[2 * i + k]; q[2 * k] = (int)rintf(bflo(w) * inv); q[2 * k + 1] = (int)rintf(bfhi(w) * inv); }
            out[i] = (unsigned)(q[0] & 255) | ((unsigned)(q[1] & 255) << 8) | ((unsigned)(q[2] & 255) << 16) | ((unsigned)(q[3] & 255) << 24); }
        *(u32x4*)(W8 + (size_t)row * 1024 + 16 * F.lane) = (u32x4){out[0], out[1], out[2], out[3]};
    }
}
DI void phase_norm_route(Frame& F, int li, const float* gain, bf16_t* H) {
    const bf16_t* X = (const bf16_t*)(F.ws + WS_X);
    const float* R = F.gin(23) + (size_t)li * 1024 * 8;
    int* r_e = (int*)(F.ws + WS_MISC + MISC_RT + 512 * 1024); int* r_rank = r_e + 2 * MTOK; float* rgate = (float*)(F.ws + WS_MISC + MISC_RT + 256 * 1024);
    unsigned* cnt = (unsigned*)(F.ws + WS_MISC + MISC_RT + 768 * 1024);
    float* sa = (float*)(F.ws + WS_MISC + MISC_RT + RT_SA);
    LAS int* l_e = (LAS int*)F.lds; LAS int* l_rank = l_e + 128; LAS int* l_base = l_e + 256;
    f32x4 g[4]; f32x4 rt[4][4][2];
#pragma unroll
    for (int j = 0; j < 4; ++j) { g[j] = *(const f32x4*)(gain + 4 * (F.lane + 64 * j));
#pragma unroll
        for (int q = 0; q < 4; ++q) { const float* rp = R + (size_t)(4 * (F.lane + 64 * j) + q) * 8; rt[j][q][0] = *(const f32x4*)rp; rt[j][q][1] = *(const f32x4*)(rp + 4); } }
    for (int blk = F.vcu; blk < MTOK / 64; blk += F.G) {
        for (int i = 0; i < 8; ++i) {
            const int lr = F.wave * 8 + i, row = blk * 64 + lr;
            f32x4 v[4]; float ss = 0.f;
#pragma unroll
            for (int j = 0; j < 4; ++j) { const u32x2 w = *(const u32x2*)(X + (size_t)row * DM + 4 * (F.lane + 64 * j)); v[j] = (f32x4){bflo(w.x), bfhi(w.x), bflo(w.y), bfhi(w.y)}; ss += (v[j][0] * v[j][0] + v[j][1] * v[j][1]) + (v[j][2] * v[j][2] + v[j][3] * v[j][3]); }
            const float rstd = 1.0f / sqrtf(wave_sum(ss) * (1.0f / DM) + 1e-6f);
            f32x4 la = {0.f, 0.f, 0.f, 0.f}, lb = {0.f, 0.f, 0.f, 0.f};
            float amx = 0.f;
#pragma unroll
            for (int j = 0; j < 4; ++j) { const f32x4 y = v[j] * rstd * g[j]; v[j] = y; amx = fmaxf(amx, fmaxf(fmaxf(fabsf(y[0]), fabsf(y[1])), fmaxf(fabsf(y[2]), fabsf(y[3]))));
#pragma unroll
                for (int q = 0; q < 4; ++q) { la += rt[j][q][0] * y[q]; lb += rt[j][q][1] * y[q]; } }
            amx = wave_max(amx); const float qsc = amx > 0.f ? amx * (1.0f / 127.0f) : 1.0f, qinv = 1.0f / qsc;
            if (F.lane == 0) sa[row] = qsc;
#pragma unroll
            for (int j = 0; j < 4; ++j) { const int q0 = (int)rintf(v[j][0] * qinv), q1 = (int)rintf(v[j][1] * qinv), q2 = (int)rintf(v[j][2] * qinv), q3 = (int)rintf(v[j][3] * qinv);
                *(unsigned*)((signed char*)H + (size_t)row * DM + 4 * (F.lane + 64 * j)) = (unsigned)(q0 & 255) | ((unsigned)(q1 & 255) << 8) | ((unsigned)(q2 & 255) << 16) | ((unsigned)(q3 & 255) << 24); }
            float lg[8];
#pragma unroll
            for (int e = 0; e < 4; ++e) { lg[e] = wave_sum(la[e]); lg[4 + e] = wave_sum(lb[e]); }
            int e0 = 0; float v0 = lg[0];
#pragma unroll
            for (int e = 1; e < 8; ++e) if (lg[e] > v0) { v0 = lg[e]; e0 = e; }
            int e1 = (e0 == 0) ? 1 : 0; float v1 = lg[e1];
#pragma unroll
            for (int e = 1; e < 8; ++e) if (e != e0 && lg[e] > v1) { v1 = lg[e]; e1 = e; }
            const float g1 = 1.0f / (1.0f + __expf(v0 - v1)), g0 = 1.0f - g1;
            if (F.lane == 0) { l_e[lr * 2] = e0; l_e[lr * 2 + 1] = e1; rgate[row * 2] = g0; rgate[row * 2 + 1] = g1; }
        }
        __syncthreads();
        { const int e = F.wave, l = F.lane;
          const bool m0 = (l_e[l] == e), m1 = (l_e[64 + l] == e);
          const unsigned long long b0 = __ballot(m0), b1 = __ballot(m1), lt = (1ull << l) - 1ull; const int n0 = __builtin_popcountll(b0);
          if (m0) l_rank[l] = __builtin_popcountll(b0 & lt);
          if (m1) l_rank[64 + l] = n0 + __builtin_popcountll(b1 & lt);
          if (l == 0) cnt[blk * 8 + e] = (unsigned)(n0 + __builtin_popcountll(b1)); }
        __syncthreads();
        if (F.tid < 128) { const int e = l_e[F.tid]; r_e[blk * 128 + F.tid] = e; r_rank[blk * 128 + F.tid] = l_rank[F.tid]; }
        __syncthreads();
    }
}
DI void moe_tiles(Frame& F, int li, int (&ts)[9]) {
    const unsigned* tot = (const unsigned*)(F.ws + WS_MISC + MISC_RT + 784 * 1024); int acc = 0;
#pragma unroll
    for (int e = 0; e < 8; ++e) { ts[e] = acc; acc += ((int)__hip_atomic_load(&tot[e], __ATOMIC_RELAXED, __HIP_MEMORY_SCOPE_AGENT) + 255) >> 8; }
    ts[8] = acc;
}
DI void phase_moe_scatter(Frame& F, int li) {
    const unsigned* cnt = (const unsigned*)(F.ws + WS_MISC + MISC_RT + 768 * 1024);
    unsigned* tot = (unsigned*)(F.ws + WS_MISC + MISC_RT + 784 * 1024);
    LAS int* pre = (LAS int*)F.lds;
    for (int i = F.tid; i < 2048; i += 512) pre[i] = (int)cnt[i];
    __syncthreads();
    int ts[9];
    { const int e = F.wave, l = F.lane;
      const int c0 = pre[(4 * l) * 8 + e], c1 = pre[(4 * l + 1) * 8 + e], c2 = pre[(4 * l + 2) * 8 + e], c3 = pre[(4 * l + 3) * 8 + e], sm = c0 + c1 + c2 + c3;
      int inc = sm;
#pragma unroll
      for (int off = 1; off < 64; off <<= 1) { const int t = __shfl_up(inc, off); if (l >= off) inc += t; }
      const int ex = inc - sm;
      pre[(4 * l) * 8 + e] = ex; pre[(4 * l + 1) * 8 + e] = ex + c0; pre[(4 * l + 2) * 8 + e] = ex + c0 + c1; pre[(4 * l + 3) * 8 + e] = ex + c0 + c1 + c2;
      if (l == 63) { pre[2048 + e] = inc; if (blockIdx.x == 0) tot[e] = (unsigned)inc; } }
    __syncthreads();
    { int acc = 0;
#pragma unroll
      for (int e = 0; e < 8; ++e) { ts[e] = acc; acc += (pre[2048 + e] + 255) >> 8; }
      ts[8] = acc; }
    const int* r_e = (const int*)(F.ws + WS_MISC + MISC_RT + 512 * 1024); const int* r_rank = r_e + 2 * MTOK; int* dest = (int*)(F.ws + WS_MISC + MISC_RT);
    int* rowtok = (int*)(F.ws + WS_MISC + MISC_RT + 800 * 1024);
    const float* sa = (const float*)(F.ws + WS_MISC + MISC_RT + RT_SA); float* sag = (float*)(F.ws + WS_MISC + MISC_RT + RT_SAG);
    for (int idx = (int)blockIdx.x * 512 + F.tid; idx < 2 * MTOK; idx += F.G * 512) {
        const int row = idx >> 1, e = r_e[idx]; int st = 0;
#pragma unroll
        for (int j = 0; j < 8; ++j) st = (e == j) ? ts[j] : st;
        const int d = st * 256 + pre[(row >> 6) * 8 + e] + r_rank[idx];
        dest[idx] = d; rowtok[d] = row; sag[d] = sa[row];
    }
    if ((int)blockIdx.x < 8) { const int e = (int)blockIdx.x, c = pre[2048 + e], pad = ((c + 255) & ~255);
        for (int r = c + F.tid; r < pad; r += 512) { rowtok[ts[e] * 256 + r] = 0; sag[ts[e] * 256 + r] = 0.f; } }
}
typedef short v4i16_t __attribute__((ext_vector_type(4)));
constexpr int VT_STRIDE = 192, VT_BYTES = 32 * VT_STRIDE;
template <int NKS, class KL, class VL, class MK>
DI void wave_attn(const bf16x8 (&qf)[NKS], int kt_lo, int kt_hi, const KL kl, const VL vl, const MK mk, float c, LAS unsigned char* vt, int lane, f32x16 (&o)[2], float& m, float& l) {
    const int hh = lane >> 5;
    bf16x8 kn[NKS]; u32x4 vn[4];
    kl(kt_lo, kn); vl(kt_lo, vn);
    LAS unsigned char* vw = vt + (lane >> 3) * VT_STRIDE + (lane & 7) * 16;
    const LAS unsigned char* vr = vt + (4 * hh + ((lane & 15) >> 2)) * VT_STRIDE + ((lane >> 4) & 1) * 32 + (lane & 3) * 8;
    for (int kt = kt_lo; kt < kt_hi; ++kt) {
        bf16x8 kf[NKS]; u32x4 vc[4];
#pragma unroll
        for (int i = 0; i < NKS; ++i) kf[i] = kn[i];
#pragma unroll
        for (int i = 0; i < 4; ++i) vc[i] = vn[i];
        if (kt + 1 < kt_hi) { kl(kt + 1, kn); vl(kt + 1, vn); }
#pragma unroll
        for (int i = 0; i < 4; ++i) *(LAS u32x4*)(vw + i * 8 * VT_STRIDE) = vc[i];
        f32x16 s;
#pragma unroll
        for (int i = 0; i < 16; ++i) s[i] = 0.f;
#pragma unroll
        for (int ks = 0; ks < NKS; ++ks) s = __builtin_amdgcn_mfma_f32_32x32x16_bf16(kf[ks], qf[ks], s, 0, 0, 0);
        mk(kt, s);
        float mx = s[0];
#pragma unroll
        for (int i = 1; i < 16; ++i) mx = fmaxf(mx, s[i]);
        mx = fmaxf(mx, __shfl_xor(mx, 32));
        const float mnew = fmaxf(m, mx);
        const float msafe = (mnew == -INFINITY) ? 0.f : mnew;
        const float alpha = __builtin_amdgcn_exp2f((m - msafe) * c);
        float ps = 0.f;
#pragma unroll
        for (int i = 0; i < 16; ++i) { s[i] = __builtin_amdgcn_exp2f((s[i] - msafe) * c); ps += s[i]; }
        l = l * alpha + ps; m = mnew;
#pragma unroll
        for (int i = 0; i < 16; ++i) { o[0][i] *= alpha; o[1][i] *= alpha; }
        bf16x8 pf[2];
#pragma unroll
        for (int s2 = 0; s2 < 2; ++s2) { u32x4 w; w.x = cvtpk(s[8 * s2], s[8 * s2 + 1]); w.y = cvtpk(s[8 * s2 + 2], s[8 * s2 + 3]); w.z = cvtpk(s[8 * s2 + 4], s[8 * s2 + 5]); w.w = cvtpk(s[8 * s2 + 6], s[8 * s2 + 7]); pf[s2] = __builtin_bit_cast(bf16x8, w); }
        LDS_WAIT();
#pragma unroll
        for (int dt = 0; dt < 2; ++dt)
#pragma unroll
            for (int s2 = 0; s2 < 2; ++s2) {
                const v4i16_t lo = __builtin_amdgcn_ds_read_tr16_b64_v4i16((LAS v4i16_t*)(vr + (16 * s2) * VT_STRIDE + dt * 64));
                const v4i16_t hi = __builtin_amdgcn_ds_read_tr16_b64_v4i16((LAS v4i16_t*)(vr + (16 * s2 + 8) * VT_STRIDE + dt * 64));
                const bf16x8 vf = {lo[0], lo[1], lo[2], lo[3], hi[0], hi[1], hi[2], hi[3]};
                o[dt] = __builtin_amdgcn_mfma_f32_32x32x16_bf16(vf, pf[s2], o[dt], 0, 0, 0);
            }
        LDS_WAIT();
    }
}
struct KLoad4 { const bf16_t* base; size_t rs; int pos0, pstep, r, hh;
    DI void operator()(int kt, bf16x8 (&kf)[4]) const { const bf16_t* p = base + (size_t)(pos0 + pstep * (kt * 32 + r)) * rs + 8 * hh;
#pragma unroll
        for (int ks = 0; ks < 4; ++ks) kf[ks] = *(const bf16x8*)(p + 16 * ks); } };
struct KLoadMla { const bf16_t* nope; const bf16_t* rope; int r, hh;
    DI void operator()(int kt, bf16x8 (&kf)[6]) const { const int key = kt * 32 + r; const bf16_t* p = nope + (size_t)key * 1024 + 8 * hh; const bf16_t* q = rope + (size_t)key * OD_NP + 8 * hh;
#pragma unroll
        for (int ks = 0; ks < 4; ++ks) kf[ks] = *(const bf16x8*)(p + 16 * ks);
        kf[4] = *(const bf16x8*)q; kf[5] = *(const bf16x8*)(q + 16); } };
struct VLoad { const bf16_t* base; size_t rs; int pos0, pstep, lane;
    DI void operator()(int kt, u32x4 (&v)[4]) const {
#pragma unroll
        for (int i = 0; i < 4; ++i) v[i] = *(const u32x4*)(base + (size_t)(pos0 + pstep * (kt * 32 + i * 8 + (lane >> 3))) * rs + (lane & 7) * 8); } };
struct MaskCausal { int mq, hh; DI void operator()(int kt, f32x16& s) const {
#pragma unroll
        for (int i = 0; i < 16; ++i) if (kt * 32 + crow(i, hh) > mq) s[i] = -INFINITY; } };
struct MaskDil { int mq, hh, j; DI void operator()(int kt, f32x16& s) const {
        if (kt != j && kt != j - 4) return;
        const int base = mq - kt * 32 - 4 * hh;
#pragma unroll
        for (int i = 0; i < 16; ++i) { if ((unsigned)(base - ((i & 3) + 8 * (i >> 2))) > 128u) s[i] = -INFINITY; } } };
struct MaskBits { const unsigned* mrow; int hh; DI void operator()(int kt, f32x16& s) const { const unsigned w = mrow[(size_t)kt * SEQ];
#pragma unroll
        for (int i = 0; i < 16; ++i) if (!((w >> crow(i, hh)) & 1u)) s[i] = -INFINITY; } };
DI void store_o(bf16_t* orow, const f32x16 (&o)[2], float inv, int hh) {
#pragma unroll
    for (int dt = 0; dt < 2; ++dt)
#pragma unroll
        for (int g = 0; g < 4; ++g) { u32x2 w; w.x = cvtpk(o[dt][4 * g] * inv, o[dt][4 * g + 1] * inv); w.y = cvtpk(o[dt][4 * g + 2] * inv, o[dt][4 * g + 3] * inv);
            *(u32x2*)(orow + 32 * dt + 8 * g + 4 * hh) = w; }
}
constexpr float LOG2E = 1.4426950408889634f;
constexpr float DEFER_THR = 8.0f;

constexpr int SCS = 2052;
DI void dsa_load_q(const bf16_t* P, int b, int g, int lane, bf16x8 (&qf)[8], u32x4& ww) {
    const bf16_t* qrow = P + (size_t)(b * SEQ + 16 * g + (lane & 15)) * EV_NP;
#pragma unroll
    for (int h = 0; h < 8; ++h) qf[h] = *(const bf16x8*)(qrow + C_QI + h * 32 + 8 * (lane >> 4));
    ww = *(const u32x4*)(qrow + C_WI);
}
DI void dsa_select_unit(Frame& F, const bf16_t* P, unsigned* maskT, int b, int g, int gnext, bf16x8 (&qf)[8], u32x4& ww) {
    LAS float* sc = (LAS float*)F.lds;
    LAS unsigned* mst = (LAS unsigned*)(F.lds + 16 * SCS * 4);
    const int lane = F.lane, w = F.wave, qi = lane & 15, kq = lane >> 4, t0 = 16 * g;
    {
        const float wv[8] = {bflo(ww.x), bfhi(ww.x), bflo(ww.y), bfhi(ww.y), bflo(ww.z), bfhi(ww.z), bflo(ww.w), bfhi(ww.w)};
        for (int rp_ = 0; rp_ < REP_SC; ++rp_) for (int kt0 = w; kt0 <= g; kt0 += 64) {
            bf16x8 kfs[8];
#pragma unroll
            for (int j = 0; j < 8; ++j) { const int kt = kt0 + 8 * j; kfs[j] = (kt <= g) ? *(const bf16x8*)(P + (size_t)(b * SEQ + kt * 16 + qi) * EV_NP + C_KI + 8 * kq) : (bf16x8){0, 0, 0, 0, 0, 0, 0, 0}; }
#pragma unroll
            for (int j = 0; j < 8; ++j) { const int kt = kt0 + 8 * j;
                if (kt <= g) {
                    f32x4 s = {0.f, 0.f, 0.f, 0.f};
#pragma unroll
                    for (int h = 0; h < 8; ++h) { const f32x4 d = __builtin_amdgcn_mfma_f32_16x16x32_bf16(kfs[j], qf[h], (f32x4){0.f, 0.f, 0.f, 0.f}, 0, 0, 0);
#pragma unroll
                        for (int r = 0; r < 4; ++r) s[r] += wv[h] * fmaxf(d[r], 0.f); }
                    *(LAS f32x4*)(sc + qi * SCS + kt * 16 + 4 * kq) = s; } }
        }
    }
    __syncthreads();
    if (gnext >= 0) dsa_load_q(P, b, gnext, lane, qf, ww);
    for (int rp_ = 0; rp_ < REP_SL; ++rp_) for (int qq = 0; qq < 2; ++qq) {
        const int q = 2 * w + qq, t = t0 + q;
        const LAS float* srow = sc + q * SCS;
        unsigned u[32];
#pragma unroll
        for (int e = 0; e < 32; ++e) { const int s = 64 * e + lane; const unsigned bits = __float_as_uint(srow[s]); const unsigned key = (bits & 0x80000000u) ? ~bits : (bits | 0x80000000u); u[e] = (s <= t) ? key : 0u; }
        unsigned mylo = 0u, myhi = 0u;
        const int E = (t >> 6) + 1;
        if (t < 256) {
#pragma unroll
            for (int e = 0; e < 32; ++e) { const unsigned long long bal = __ballot(u[e] != 0u); if (lane == e) { mylo = (unsigned)bal; myhi = (unsigned)(bal >> 32); } }
        } else {
            unsigned T = 0u; bool exact = false;
            for (int bit = 31; bit >= 0; --bit) {
                const unsigned cand = T | (1u << bit); int cn = 0, cv = 0;
#pragma unroll
                for (int gi = 0; gi < 4; ++gi) if (gi * 8 < E) {
#pragma unroll
                    for (int e = 8 * gi; e < 8 * gi + 3; ++e) cn += __builtin_popcountll(__ballot(u[e] >= cand));
#pragma unroll
                    for (int e = 8 * gi + 3; e < 8 * gi + 8; ++e) cv += (u[e] >= cand) ? 1 : 0; }
                cn += wave_sum_i32(cv);
                if (cn >= 256) { T = cand; if (cn == 256) { exact = true; break; } }
            }
            if (exact) {
#pragma unroll
                for (int e = 0; e < 32; ++e) { const unsigned long long bal = __ballot(u[e] >= T); if (lane == e) { mylo = (unsigned)bal; myhi = (unsigned)(bal >> 32); } }
            } else {
                int cgt = 0;
#pragma unroll
                for (int e = 0; e < 32; ++e) cgt += __builtin_popcountll(__ballot(u[e] > T));
                const int need = 256 - cgt; int running = 0;
#pragma unroll
                for (int e = 0; e < 32; ++e) { const unsigned long long eq = __ballot(u[e] == T);
                    const int before = running + (int)__builtin_amdgcn_mbcnt_hi((unsigned)(eq >> 32), __builtin_amdgcn_mbcnt_lo((unsigned)eq, 0u));
                    const bool sel = (u[e] > T) || (u[e] == T && before < need);
                    const unsigned long long bal = __ballot(sel); if (lane == e) { mylo = (unsigned)bal; myhi = (unsigned)(bal >> 32); }
                    running += __builtin_popcountll(eq); }
            }
        }
        if (lane < 32) { mst[q * 64 + 2 * lane] = mylo; mst[q * 64 + 2 * lane + 1] = myhi; }
    }
    __syncthreads();
    for (int idx = F.tid; idx < 1024; idx += 512) { const int kt = idx >> 4, q = idx & 15; maskT[(size_t)(b * 64 + kt) * SEQ + t0 + q] = mst[q * 64 + kt]; }
    __syncthreads();
}
DI void dsa_attn_unit(Frame& F, const bf16_t* P, const unsigned* maskT, bf16_t* MIX, int bh, int j) {
    const int lane = F.lane, r = lane & 31, hh = lane >> 5, b = bh >> 3, hq = bh & 7, n = hq >> 2;
    const bf16_t* Pb = P + (size_t)b * SEQ * EV_NP;
    const int tq = 32 * j + r;
    bf16x8 qf[4];
#pragma unroll
    for (int ks = 0; ks < 4; ++ks) qf[ks] = *(const bf16x8*)(Pb + (size_t)tq * EV_NP + C_QA + hq * 64 + 16 * ks + 8 * hh);
    f32x16 o[2];
#pragma unroll
    for (int i = 0; i < 16; ++i) { o[0][i] = 0.f; o[1][i] = 0.f; }
    float m = -INFINITY, l = 0.f;
    wave_attn<4>(qf, 0, j + 1, KLoad4{Pb + C_KA + n * 64, (size_t)EV_NP, 0, 1, r, hh}, VLoad{Pb + C_VA + n * 64, (size_t)EV_NP, 0, 1, lane},
                 MaskBits{maskT + (size_t)b * 64 * SEQ + tq, hh}, 0.125f * LOG2E, F.lds + F.wave * VT_BYTES, lane, o, m, l);
    l += __shfl_xor(l, 32);
    store_o(MIX + (size_t)(b * SEQ + tq) * DM + hq * 64, o, 1.0f / l, hh);
}
DI void dil_attn_unit(Frame& F, const bf16_t* P, bf16_t* DO, float* DL, int br, int bh, int jt) {
    const int lane = F.lane, r = lane & 31, hh = lane >> 5, b = bh >> 3, h = bh & 7;
    const int d = (br == 0) ? 1 : (br == 1 ? 4 : 16), tpc = 64 / d, cls = jt / tpc, j = jt % tpc;
    const bf16_t* Pb = P + (size_t)b * SEQ * EV_NP;
    const int mq = 32 * j + r, tq = cls + d * mq;
    bf16x8 qf[4];
#pragma unroll
    for (int ks = 0; ks < 4; ++ks) qf[ks] = *(const bf16x8*)(Pb + (size_t)tq * EV_NP + C_QB + h * 64 + 16 * ks + 8 * hh);
    f32x16 o[2];
#pragma unroll
    for (int i = 0; i < 16; ++i) { o[0][i] = 0.f; o[1][i] = 0.f; }
    float m = -INFINITY, l = 0.f;
    wave_attn<4>(qf, (j - 4 > 0 ? j - 4 : 0), j + 1, KLoad4{Pb + C_KB + h * 64, (size_t)EV_NP, cls, d, r, hh}, VLoad{Pb + C_VB + h * 64, (size_t)EV_NP, cls, d, lane},
                 MaskDil{mq, hh, j}, 0.125f * LOG2E, F.lds + F.wave * VT_BYTES, lane, o, m, l);
    l += __shfl_xor(l, 32);
    const size_t tok = (size_t)(b * SEQ + tq);
    store_o(DO + ((size_t)br * MTOK + tok) * 512 + h * 64, o, 1.0f / l, hh);
    if (hh == 0) DL[((size_t)br * MTOK + tok) * 8 + h] = m * (0.125f * LOG2E) + __builtin_amdgcn_logf(l);
}
template <int NKS, class MK>
DI void attn_tile_step(const bf16x8 (&kf)[NKS], const u32x4 (&vc)[4], const bf16x8 (&qf)[NKS], const MK mk, int kt, float c, LAS unsigned char* vt, int lane, f32x16 (&o)[2], float& m, float& l) {
    const int hh = lane >> 5;
    LAS unsigned char* vw = vt + (lane >> 3) * VT_STRIDE + (lane & 7) * 16;
    const LAS unsigned char* vr = vt + (4 * hh + ((lane & 15) >> 2)) * VT_STRIDE + ((lane >> 4) & 1) * 32 + (lane & 3) * 8;
#pragma unroll
    for (int i = 0; i < 4; ++i) *(LAS u32x4*)(vw + i * 8 * VT_STRIDE) = vc[i];
    f32x16 s;
#pragma unroll
    for (int i = 0; i < 16; ++i) s[i] = 0.f;
#pragma unroll
    for (int ks = 0; ks < NKS; ++ks) s = __builtin_amdgcn_mfma_f32_32x32x16_bf16(kf[ks], qf[ks], s, 0, 0, 0);
    mk(kt, s);
    const float mx = xhalf_max(tree_max16(s));
    if (__any((mx - m) * c > DEFER_THR)) {
        const float mnew = fmaxf(m, mx), ms = (mnew == -INFINITY) ? 0.f : mnew, alpha = __builtin_amdgcn_exp2f((m - ms) * c);
        l *= alpha; m = mnew;
#pragma unroll
        for (int i = 0; i < 16; ++i) { o[0][i] *= alpha; o[1][i] *= alpha; }
    }
    const float nmc = -((m == -INFINITY) ? 0.f : m) * c;
#pragma unroll
    for (int i = 0; i < 16; ++i) s[i] = __builtin_amdgcn_exp2f(__builtin_fmaf(s[i], c, nmc));
    l += tree_sum16(s);
    bf16x8 pf[2];
#pragma unroll
    for (int s2 = 0; s2 < 2; ++s2) { u32x4 w; w.x = cvtpk(s[8 * s2], s[8 * s2 + 1]); w.y = cvtpk(s[8 * s2 + 2], s[8 * s2 + 3]); w.z = cvtpk(s[8 * s2 + 4], s[8 * s2 + 5]); w.w = cvtpk(s[8 * s2 + 6], s[8 * s2 + 7]); pf[s2] = __builtin_bit_cast(bf16x8, w); }
    LDS_WAIT();
#pragma unroll
    for (int dt = 0; dt < 2; ++dt)
#pragma unroll
        for (int s2 = 0; s2 < 2; ++s2) {
            const v4i16_t lo = __builtin_amdgcn_ds_read_tr16_b64_v4i16((LAS v4i16_t*)(vr + (16 * s2) * VT_STRIDE + dt * 64));
            const v4i16_t hi = __builtin_amdgcn_ds_read_tr16_b64_v4i16((LAS v4i16_t*)(vr + (16 * s2 + 8) * VT_STRIDE + dt * 64));
            const bf16x8 vf = {lo[0], lo[1], lo[2], lo[3], hi[0], hi[1], hi[2], hi[3]};
            o[dt] = __builtin_amdgcn_mfma_f32_32x32x16_bf16(vf, pf[s2], o[dt], 0, 0, 0);
        }
    LDS_WAIT();
}
struct DilUnit { const bf16_t* Pb; int b, h, br, d, cls, j, mq, tq, lo, n; };
DI DilUnit dil_decode(const bf16_t* P, int u, int lane) {
    DilUnit x; const int br = u / 4096, q = u % 4096, bh = q >> 6; int jt = q & 63; jt = (jt & 1) ? 63 - (jt >> 1) : (jt >> 1);
    x.br = br; x.b = bh >> 3; x.h = bh & 7; x.d = (br == 0) ? 1 : (br == 1 ? 4 : 16); const int tpc = 64 / x.d; x.cls = jt / tpc; x.j = jt % tpc;
    x.Pb = P + (size_t)x.b * SEQ * EV_NP; x.mq = 32 * x.j + (lane & 31); x.tq = x.cls + x.d * x.mq; x.lo = (x.j - 4 > 0) ? x.j - 4 : 0; x.n = x.j + 1 - x.lo; return x;
}
DI void dil_attn_pair(Frame& F, const bf16_t* P, bf16_t* DO, float* DL, int uA, int uB) {
    const int lane = F.lane, r = lane & 31, hh = lane >> 5;
    const DilUnit A = dil_decode(P, uA, lane), B = dil_decode(P, uB, lane);
    LAS unsigned char* vtA = F.lds + F.wave * 2 * VT_BYTES; LAS unsigned char* vtB = vtA + VT_BYTES;
    bf16x8 qA[4], qB[4], kA[4], kB[4]; u32x4 vA[4], vB[4];
#pragma unroll
    for (int ks = 0; ks < 4; ++ks) { qA[ks] = *(const bf16x8*)(A.Pb + (size_t)A.tq * EV_NP + C_QB + A.h * 64 + 16 * ks + 8 * hh); qB[ks] = *(const bf16x8*)(B.Pb + (size_t)B.tq * EV_NP + C_QB + B.h * 64 + 16 * ks + 8 * hh); }
    const KLoad4 klA{A.Pb + C_KB + A.h * 64, (size_t)EV_NP, A.cls, A.d, r, hh}, klB{B.Pb + C_KB + B.h * 64, (size_t)EV_NP, B.cls, B.d, r, hh};
    const VLoad vlA{A.Pb + C_VB + A.h * 64, (size_t)EV_NP, A.cls, A.d, lane}, vlB{B.Pb + C_VB + B.h * 64, (size_t)EV_NP, B.cls, B.d, lane};
    f32x16 oA[2], oB[2];
#pragma unroll
    for (int i = 0; i < 16; ++i) { oA[0][i] = 0.f; oA[1][i] = 0.f; oB[0][i] = 0.f; oB[1][i] = 0.f; }
    float mA = -INFINITY, lA = 0.f, mB = -INFINITY, lB = 0.f;
    const float c = 0.125f * LOG2E;
    klA(A.lo, kA); vlA(A.lo, vA);
    for (int i = 0; i < 5; ++i) {
        if (i < B.n) { klB(B.lo + i, kB); vlB(B.lo + i, vB); }
        if (i < A.n) attn_tile_step<4>(kA, vA, qA, MaskDil{A.mq, hh, A.j}, A.lo + i, c, vtA, lane, oA, mA, lA);
        if (i + 1 < A.n) { klA(A.lo + i + 1, kA); vlA(A.lo + i + 1, vA); }
        if (i < B.n) attn_tile_step<4>(kB, vB, qB, MaskDil{B.mq, hh, B.j}, B.lo + i, c, vtB, lane, oB, mB, lB);
    }
    lA = xhalf_sum(lA); lB = xhalf_sum(lB);
    { const size_t tok = (size_t)(A.b * SEQ + A.tq); store_o(DO + ((size_t)A.br * MTOK + tok) * 512 + A.h * 64, oA, 1.0f / lA, hh);
      if (hh == 0) DL[((size_t)A.br * MTOK + tok) * 8 + A.h] = mA * c + __builtin_amdgcn_logf(lA); }
    { const size_t tok = (size_t)(B.b * SEQ + B.tq); store_o(DO + ((size_t)B.br * MTOK + tok) * 512 + B.h * 64, oB, 1.0f / lB, hh);
      if (hh == 0) DL[((size_t)B.br * MTOK + tok) * 8 + B.h] = mB * c + __builtin_amdgcn_logf(lB); }
}
DI void phase_dil_merge(Frame& F, const bf16_t* DO, const float* DL, bf16_t* MIX) {
    for (int idx = F.gw * 64 + F.lane; idx < MTOK * 64; idx += F.NGW * 64) {
        const int tok = idx >> 6, h = (idx >> 3) & 7, c8 = idx & 7;
        float ls[3];
#pragma unroll
        for (int br = 0; br < 3; ++br) ls[br] = DL[((size_t)br * MTOK + tok) * 8 + h];
        const float mx = fmaxf(ls[0], fmaxf(ls[1], ls[2]));
        float wgt[3], ws = 0.f;
#pragma unroll
        for (int br = 0; br < 3; ++br) { wgt[br] = __builtin_amdgcn_exp2f(ls[br] - mx); ws += wgt[br]; }
        const float inv = 1.0f / ws;
        float acc[8];
#pragma unroll
        for (int k = 0; k < 8; ++k) acc[k] = 0.f;
#pragma unroll
        for (int br = 0; br < 3; ++br) { const u32x4 v = *(const u32x4*)(DO + ((size_t)br * MTOK + tok) * 512 + h * 64 + c8 * 8); const float wq = wgt[br] * inv;
            acc[0] += wq * bflo(v.x); acc[1] += wq * bfhi(v.x); acc[2] += wq * bflo(v.y); acc[3] += wq * bfhi(v.y); acc[4] += wq * bflo(v.z); acc[5] += wq * bfhi(v.z); acc[6] += wq * bflo(v.w); acc[7] += wq * bfhi(v.w); }
        u32x4 w; w.x = cvtpk(acc[0], acc[1]); w.y = cvtpk(acc[2], acc[3]); w.z = cvtpk(acc[4], acc[5]); w.w = cvtpk(acc[6], acc[7]);
        *(u32x4*)(MIX + (size_t)tok * DM + 512 + h * 64 + c8 * 8) = w;
    }
}
DI void mla_attn_unit(Frame& F, const bf16_t* Q2, const bf16_t* KV2, const bf16_t* P2, bf16_t* MIX, int bh, int j) {
    const int lane = F.lane, r = lane & 31, hh = lane >> 5, b = bh >> 3, h = bh & 7;
    const int tq = 32 * j + r; const size_t tok = (size_t)(b * SEQ + tq);
    bf16x8 qf[6];
#pragma unroll
    for (int ks = 0; ks < 4; ++ks) qf[ks] = *(const bf16x8*)(Q2 + tok * 768 + h * 64 + 16 * ks + 8 * hh);
    qf[4] = *(const bf16x8*)(Q2 + tok * 768 + 512 + h * 32 + 8 * hh); qf[5] = *(const bf16x8*)(Q2 + tok * 768 + 512 + h * 32 + 16 + 8 * hh);
    f32x16 o[2];
#pragma unroll
    for (int i = 0; i < 16; ++i) { o[0][i] = 0.f; o[1][i] = 0.f; }
    float m = -INFINITY, l = 0.f;
    const bf16_t* kvb = KV2 + (size_t)b * SEQ * 1024 + h * 128;
    wave_attn<6>(qf, 0, j + 1, KLoadMla{kvb, P2 + (size_t)b * SEQ * OD_NP + C_KR, r, hh}, VLoad{kvb + 64, (size_t)1024, 0, 1, lane},
                 MaskCausal{tq, hh}, 0.10206207261596577f * LOG2E, F.lds + F.wave * VT_BYTES, lane, o, m, l);
    l += __shfl_xor(l, 32);
    store_o(MIX + tok * DM + h * 64, o, 1.0f / l, hh);
}
DI void phase_rg_carry(Frame& F, const float* aggp, float* hin, int blk8) {
    const int gid = blk8 * 512 + F.tid, b = gid >> 9, ch = gid & 511;
    float h = 0.f;
    for (int k0 = 0; k0 < 64; k0 += 16) {
        f32x2 ah[16];
#pragma unroll
        for (int i = 0; i < 16; ++i) ah[i] = *(const f32x2*)(aggp + ((size_t)(b * 64 + k0 + i) * 512 + ch) * 2);
#pragma unroll
        for (int i = 0; i < 16; ++i) { hin[(size_t)(b * 64 + k0 + i) * 512 + ch] = h; h = ah[i][0] * h + ah[i][1]; }
    }
}
template <int MODE, int RIDE> DI void block_attn_unit(Frame& F, CvtRider& rd, const bf16_t* Qb, const bf16_t* Kb, const bf16_t* Kr, const bf16_t* Vb, const unsigned* mrow, bf16_t* Ob, int bsel, int hsel, int qb) {
    constexpr int NKS = MODE == 0 ? 6 : 4, KS = NKS * 32 + 16, VS = 192, KBYTES = 64 * KS, STAGE = KBYTES + 64 * VS;
    constexpr size_t krs = MODE == 0 ? 1024 : EV_NP, vrs = krs;
    const int tid = F.tid, lane = F.lane, w = F.wave, r = lane & 31, hh = lane >> 5;
    const int q0w = MODE == 0 ? 256 * qb + 32 * w : 64 * qb + 32 * (w & 1);
    const int nt = MODE == 0 ? 4 * (qb + 1) : qb + 1, tw = (q0w + 31) >> 6;
    const int tq = q0w + r;
    bf16x8 qf[NKS];
    if (MODE == 0) {
        const bf16_t* qp = Qb + (size_t)(bsel * SEQ + tq) * 768;
#pragma unroll
        for (int ks = 0; ks < 4; ++ks) qf[ks] = *(const bf16x8*)(qp + hsel * 64 + 16 * ks + 8 * hh);
        qf[4] = *(const bf16x8*)(qp + 512 + hsel * 32 + 8 * hh); qf[5] = *(const bf16x8*)(qp + 512 + hsel * 32 + 16 + 8 * hh);
    } else {
        const bf16_t* qp = Qb + (size_t)(bsel * SEQ + tq) * EV_NP + C_QA + (hsel * 4 + (w >> 1)) * 64;
#pragma unroll
        for (int ks = 0; ks < 4; ++ks) qf[ks] = *(const bf16x8*)(qp + 16 * ks + 8 * hh);
    }
    const bf16_t* kg = Kb + (size_t)(tid >> 3) * krs + (tid & 7) * 8;
    const bf16_t* vg = Vb + (size_t)(tid >> 3) * vrs + (tid & 7) * 8;
    const bf16_t* rg = (MODE == 0) ? Kr + (size_t)(tid >> 2) * OD_NP + (tid & 3) * 8 : nullptr;
    LAS unsigned char* base = F.lds;
    const int kw = (tid >> 3) * KS + (tid & 7) * 16, vw = KBYTES + (tid >> 3) * VS + (tid & 7) * 16, rw = (tid >> 2) * KS + 128 + (tid & 3) * 16;
    const int ka = r * KS + 16 * hh;
    const int va = KBYTES + (4 * hh + ((lane & 15) >> 2)) * VS + ((lane >> 4) & 1) * 32 + (lane & 3) * 8;
    const float c = (MODE == 0 ? 0.10206207261596577f : 0.125f) * LOG2E;
    f32x16 o[2];
#pragma unroll
    for (int i = 0; i < 16; ++i) { o[0][i] = 0.f; o[1][i] = 0.f; }
    float m = -INFINITY, l = 0.f;
#define BA_COMPUTE \
        if (t <= tw) { \
            unsigned w0 = 0xffffffffu, w1 = 0xffffffffu; \
            if (MODE == 1) { w0 = mrow[(size_t)(2 * t) * SEQ + tq]; w1 = mrow[(size_t)(2 * t + 1) * SEQ + tq]; } \
            f32x16 s0, s1; \
        _Pragma("unroll") \
            for (int i = 0; i < 16; ++i) { s0[i] = 0.f; s1[i] = 0.f; } \
            bf16x8 ka0[NKS], ka1[NKS]; \
        _Pragma("unroll") \
            for (int ks = 0; ks < NKS; ++ks) { ka0[ks] = *(const LAS bf16x8*)(cur + ka + 32 * ks); ka1[ks] = *(const LAS bf16x8*)(cur + ka + 32 * KS + 32 * ks); } \
            asm volatile("s_waitcnt lgkmcnt(0)" ::: "memory"); __builtin_amdgcn_sched_barrier(0); \
        _Pragma("unroll") \
            for (int ks = 0; ks < NKS; ++ks) { s0 = __builtin_amdgcn_mfma_f32_32x32x16_bf16(ka0[ks], qf[ks], s0, 0, 0, 0); s1 = __builtin_amdgcn_mfma_f32_32x32x16_bf16(ka1[ks], qf[ks], s1, 0, 0, 0); } \
            if (MODE == 0) { if (64 * t + 63 > q0w) { \
        _Pragma("unroll") \
                for (int i = 0; i < 16; ++i) { const int key = 64 * t + crow(i, hh); if (key > tq) s0[i] = -INFINITY; if (key + 32 > tq) s1[i] = -INFINITY; } } } \
            else { \
        _Pragma("unroll") \
                for (int i = 0; i < 16; ++i) { const unsigned b0 = (unsigned)__builtin_amdgcn_sbfe((int)(w0 >> (4 * hh)), (i & 3) + 8 * (i >> 2), 1), b1 = (unsigned)__builtin_amdgcn_sbfe((int)(w1 >> (4 * hh)), (i & 3) + 8 * (i >> 2), 1); \
                    s0[i] = __uint_as_float((__float_as_uint(s0[i]) & b0) | (0xff800000u & ~b0)); s1[i] = __uint_as_float((__float_as_uint(s1[i]) & b1) | (0xff800000u & ~b1)); } } \
            const float mx = xhalf_max(fmaxf(tree_max16(s0), tree_max16(s1))); \
            if (__any((mx - m) * c > DEFER_THR)) { const float mnew = fmaxf(m, mx), ms = (mnew == -INFINITY) ? 0.f : mnew, alpha = __builtin_amdgcn_exp2f((m - ms) * c); l *= alpha; m = mnew;        \
        _Pragma("unroll") \
                for (int i = 0; i < 16; ++i) { o[0][i] *= alpha; o[1][i] *= alpha; } } \
            const float nmc = -((m == -INFINITY) ? 0.f : m) * c; \
        _Pragma("unroll") \
            for (int i = 0; i < 16; ++i) { s0[i] = __builtin_amdgcn_exp2f(__builtin_fmaf(s0[i], c, nmc)); s1[i] = __builtin_amdgcn_exp2f(__builtin_fmaf(s1[i], c, nmc)); } \
            l += tree_sum16(s0) + tree_sum16(s1); \
            bf16x8 pf[4]; \
        _Pragma("unroll") \
            for (int s2 = 0; s2 < 2; ++s2) { \
                u32x4 a; a.x = cvtpk(s0[8 * s2], s0[8 * s2 + 1]); a.y = cvtpk(s0[8 * s2 + 2], s0[8 * s2 + 3]); a.z = cvtpk(s0[8 * s2 + 4], s0[8 * s2 + 5]); a.w = cvtpk(s0[8 * s2 + 6], s0[8 * s2 + 7]); pf[s2] = __builtin_bit_cast(bf16x8, a); \
                u32x4 b; b.x = cvtpk(s1[8 * s2], s1[8 * s2 + 1]); b.y = cvtpk(s1[8 * s2 + 2], s1[8 * s2 + 3]); b.z = cvtpk(s1[8 * s2 + 4], s1[8 * s2 + 5]); b.w = cvtpk(s1[8 * s2 + 6], s1[8 * s2 + 7]); pf[2 + s2] = __builtin_bit_cast(bf16x8, b); } \
        _Pragma("unroll") \
            for (int dt = 0; dt < 2; ++dt) \
        _Pragma("unroll") \
                for (int kk = 0; kk < 4; ++kk) { \
                    const v4i16_t lo = __builtin_amdgcn_ds_read_tr16_b64_v4i16((LAS v4i16_t*)(cur + va + (16 * kk) * VS + dt * 64)); \
                    const v4i16_t hi = __builtin_amdgcn_ds_read_tr16_b64_v4i16((LAS v4i16_t*)(cur + va + (16 * kk + 8) * VS + dt * 64)); \
                    const bf16x8 vf = {lo[0], lo[1], lo[2], lo[3], hi[0], hi[1], hi[2], hi[3]}; \
                    o[dt] = __builtin_amdgcn_mfma_f32_32x32x16_bf16(vf, pf[kk], o[dt], 0, 0, 0); \
                } \
        }
    u32x4 kA, vA, rA = {0u, 0u, 0u, 0u}, kB = {0u, 0u, 0u, 0u}, vB = {0u, 0u, 0u, 0u}, rB = {0u, 0u, 0u, 0u};
#define BA_LOAD(K_, V_, R_, tt) do { K_ = *(const u32x4*)(kg + (size_t)(tt) * 64 * krs); V_ = *(const u32x4*)(vg + (size_t)(tt) * 64 * vrs); if (MODE == 0 && tid < 256) R_ = *(const u32x4*)(rg + (size_t)(tt) * 64 * OD_NP); } while (0)
#define BA_WRITE(K_, V_, R_, dst) do { *(LAS u32x4*)((dst) + kw) = K_; *(LAS u32x4*)((dst) + vw) = V_; if (MODE == 0 && tid < 256) *(LAS u32x4*)((dst) + rw) = R_; } while (0)
    BA_LOAD(kA, vA, rA, 0);
    BA_WRITE(kA, vA, rA, base);
    if (nt > 1) BA_LOAD(kA, vA, rA, 1);
    __syncthreads();
#define BA_ITER(KX, VX, RX, KY, VY, RY) do { \
        const LAS unsigned char* cur = base + (t & 1) * STAGE; LAS unsigned char* nxt = base + ((t + 1) & 1) * STAGE; \
        if (t + 2 < nt) BA_LOAD(KY, VY, RY, t + 2); \
        CvtDesc rdd{}; f32x4 rdv[8]; bool rdh = false; \
        if (RIDE != 0) { rdh = rd.it < rd.end; if (rdh) { rdd = (RIDE == 1) ? cvt_odd_desc(F, rd.li, rd.it) : cvt_even_desc(F, rd.li, rd.it); cvt_load(rdd, lane, rdv); } } \
        BA_COMPUTE \
        if (RIDE != 0) { if (rdh) { cvt_store(rdd, lane, rdv); rd.it += F.NGW; } } \
        if (t + 1 < nt) BA_WRITE(KX, VX, RX, nxt); \
        __syncthreads(); } while (0)
    for (int t = 0; t < nt; t += 2) {
        BA_ITER(kA, vA, rA, kB, vB, rB);
        ++t; if (t < nt) BA_ITER(kB, vB, rB, kA, vA, rA);
        --t;
    }
#undef BA_ITER
#undef BA_LOAD
#undef BA_WRITE
#undef BA_COMPUTE
    l = xhalf_sum(l);
    store_o(Ob, o, 1.0f / l, hh);
}
DI void phase_mla_norm(Frame& F, int li, const bf16_t* P2, bf16_t* CQN, bf16_t* CKVN) {
    const float* gq = F.gin(10) + li * 256; const float* gkv = F.gin(12) + li * 128;
    const f32x4 g4 = *(const f32x4*)(gq + 4 * F.lane); const f32x2 g2 = *(const f32x2*)(gkv + 2 * F.lane);
    for (int row = F.gw; row < MTOK; row += F.NGW) {
        const u32x2 a = *(const u32x2*)(P2 + (size_t)row * OD_NP + C_CQ + 4 * F.lane); const unsigned kv = *(const unsigned*)(P2 + (size_t)row * OD_NP + C_CKV + 2 * F.lane);
        const float q0 = bflo(a.x), q1 = bfhi(a.x), q2 = bflo(a.y), q3 = bfhi(a.y), k0 = bflo(kv), k1 = bfhi(kv);
        const float sq = wave_sum(q0 * q0 + q1 * q1 + q2 * q2 + q3 * q3), sk = wave_sum(k0 * k0 + k1 * k1);
        const float rq = 1.0f / sqrtf(sq * (1.0f / 256.0f) + 1e-6f), rk = 1.0f / sqrtf(sk * (1.0f / 128.0f) + 1e-6f);
        u32x2 w; w.x = cvtpk(q0 * rq * g4[0], q1 * rq * g4[1]); w.y = cvtpk(q2 * rq * g4[2], q3 * rq * g4[3]);
        *(u32x2*)(CQN + (size_t)row * 256 + 4 * F.lane) = w;
        *(unsigned*)(CKVN + (size_t)row * 256 + 2 * F.lane) = cvtpk(k0 * rk * g2[0], k1 * rk * g2[1]);
        *(unsigned*)(CKVN + (size_t)row * 256 + 128 + 2 * F.lane) = 0u;
    }
}
constexpr int XS_STRIDE = 68, XS_BYTES = 32 * XS_STRIDE * 4;
template <bool FINAL> DI void rg_unit(Frame& F, int li, int b, int k, int n, const bf16_t* P2, const bf16_t* wt, float* agg, bf16_t* MIX) {
    const int lane = F.lane, r = lane & 31, hh = lane >> 5, t0 = 32 * k, row0 = b * SEQ + t0;
    LAS float* xs = (LAS float*)(F.lds + 65536 + F.wave * XS_BYTES);
    const float* cw = F.gin(14) + li * 4 * 512; const float* cb = F.gin(15) + li * 512; const float* ba = F.gin(17) + li * 512; const float* bx = F.gin(19) + li * 512; const float* lam = F.gin(20) + li * 512;
    float gpre[2][16], hpre[2] = {0.f, 0.f};
    if (FINAL) {
#pragma unroll
        for (int jn = 0; jn < 2; ++jn) { const int ch = n * 64 + jn * 32 + r; hpre[jn] = agg[(size_t)1024 * 1024 * 3 / 4 + (size_t)(b * 64 + k) * 512 + ch];
#pragma unroll
            for (int i = 0; i < 16; ++i) gpre[jn][i] = bf2f(P2[(size_t)(row0 + crow(i, hh)) * OD_NP + C_GR + ch]); }
    }
    bf16x8 af[4];
#pragma unroll
    for (int ks = 0; ks < 4; ++ks) {
        const int ch = n * 64 + 16 * ks + 8 * hh;
        float xc[8]; { const f32x4 c0 = *(const f32x4*)(cb + ch), c1 = *(const f32x4*)(cb + ch + 4); xc[0] = c0[0]; xc[1] = c0[1]; xc[2] = c0[2]; xc[3] = c0[3]; xc[4] = c1[0]; xc[5] = c1[1]; xc[6] = c1[2]; xc[7] = c1[3]; }
#pragma unroll
        for (int w = 0; w < 4; ++w) { const int tt = t0 + r - 3 + w;
            if (tt >= 0) { const u32x4 xv = *(const u32x4*)(P2 + (size_t)(b * SEQ + tt) * OD_NP + C_XR + ch); const f32x4 w0 = *(const f32x4*)(cw + w * 512 + ch), w1 = *(const f32x4*)(cw + w * 512 + ch + 4);
                xc[0] += w0[0] * bflo(xv.x); xc[1] += w0[1] * bfhi(xv.x); xc[2] += w0[2] * bflo(xv.y); xc[3] += w0[3] * bfhi(xv.y); xc[4] += w1[0] * bflo(xv.z); xc[5] += w1[1] * bfhi(xv.z); xc[6] += w1[2] * bflo(xv.w); xc[7] += w1[3] * bfhi(xv.w); } }
        u32x4 w; w.x = cvtpk(xc[0], xc[1]); w.y = cvtpk(xc[2], xc[3]); w.z = cvtpk(xc[4], xc[5]); w.w = cvtpk(xc[6], xc[7]); af[ks] = __builtin_bit_cast(bf16x8, w);
        *(LAS f32x4*)(xs + r * XS_STRIDE + 16 * ks + 8 * hh) = (f32x4){xc[0], xc[1], xc[2], xc[3]}; *(LAS f32x4*)(xs + r * XS_STRIDE + 16 * ks + 8 * hh + 4) = (f32x4){xc[4], xc[5], xc[6], xc[7]};
    }
    LDS_WAIT();
#pragma unroll
    for (int jn = 0; jn < 2; ++jn) {
        f32x16 da, dx;
#pragma unroll
        for (int i = 0; i < 16; ++i) { da[i] = 0.f; dx[i] = 0.f; }
#pragma unroll
        for (int ks = 0; ks < 4; ++ks) { const bf16x8 wa = *(const bf16x8*)(wt + (size_t)((n * 64 + jn * 32 + r) * 64) + 16 * ks + 8 * hh), wx = *(const bf16x8*)(wt + (size_t)(((8 + n) * 64 + jn * 32 + r) * 64) + 16 * ks + 8 * hh);
            da = __builtin_amdgcn_mfma_f32_32x32x16_bf16(af[ks], wa, da, 0, 0, 0); dx = __builtin_amdgcn_mfma_f32_32x32x16_bf16(af[ks], wx, dx, 0, 0, 0); }
        const int ch = n * 64 + jn * 32 + r;
        const float cl = -8.0f * log1pf(__expf(-lam[ch])), bav = ba[ch], bxv = bx[ch];
        float a[16], u[16];
#pragma unroll
        for (int i = 0; i < 16; ++i) { const int tok = crow(i, hh);
            const float rr = __builtin_amdgcn_rcpf(1.0f + __expf(-(da[i] + bav))), ig = __builtin_amdgcn_rcpf(1.0f + __expf(-(dx[i] + bxv))), xcv = xs[tok * XS_STRIDE + jn * 32 + r];
            const float la = cl * rr; a[i] = __expf(la); u[i] = __builtin_amdgcn_sqrtf(fmaxf((1.0f - a[i]) * (1.0f + a[i]), 0.f)) * (ig * xcv); }
        float Ag[4], Hg[4];
#pragma unroll
        for (int g = 0; g < 4; ++g) { float A = 1.f, H = 0.f;
#pragma unroll
            for (int e = 0; e < 4; ++e) { A *= a[4 * g + e]; H = a[4 * g + e] * H + u[4 * g + e]; } Ag[g] = A; Hg[g] = H; }
        float hin = 0.f;
        if (FINAL) hin = hpre[jn];
        float S = hin, Aall = 1.f, st[4];
#pragma unroll
        for (int g = 0; g < 4; ++g) { const float pA = __shfl_xor(Ag[g], 32), pH = __shfl_xor(Hg[g], 32);
            const float A0 = hh ? pA : Ag[g], H0 = hh ? pH : Hg[g], A1 = hh ? Ag[g] : pA, H1 = hh ? Hg[g] : pH;
            const float s0 = S; S = A0 * S + H0; const float s1 = S; S = A1 * S + H1; Aall *= A0 * A1; st[g] = hh ? s1 : s0; }
        if (!FINAL) { if (hh == 0) *(f32x2*)(agg + ((size_t)(b * 64 + k) * 512 + ch) * 2) = (f32x2){Aall, S}; }
        else {
#pragma unroll
            for (int g = 0; g < 4; ++g) { float hcur = st[g];
#pragma unroll
                for (int e = 0; e < 4; ++e) { const int i = 4 * g + e, tok = crow(i, hh); hcur = a[i] * hcur + u[i];
                    const float gt = gpre[jn][i];
                    const float y = 0.7978845608028654f * (gt + 0.044715f * gt * gt * gt), th = 1.0f - 2.0f * __builtin_amdgcn_rcpf(1.0f + __expf(2.0f * y)), ge = 0.5f * gt * (1.0f + th);
                    MIX[(size_t)(row0 + tok) * DM + 512 + ch] = (bf16_t)(cvtpk(hcur * ge, 0.f) & 0xffffu); } }
        }
    }
    LDS_WAIT();
}

constexpr int NPH_PAIR = 18, NPH = 2 * NPH_PAIR + 1;
#ifndef PH_EN
#define PH_EN 0x3ffffull
#endif
#define IN(k) ((((PH_EN) >> (((k) >= 2 * NPH_PAIR) ? 0 : ((k) % NPH_PAIR))) & 1ull) && args.ph_lo <= (k) && (k) < args.ph_hi)
#ifndef PROBE_MASK
#define PROBE_MASK 0ull
#endif
#ifndef PROBE_MUL
#define PROBE_MUL 2
#endif
#define PROBE_STAMP(k) do { if (PROBE_MASK != 0ull && blockIdx.x == 0 && threadIdx.x == 0) { volatile LAS unsigned long long* pt = (volatile LAS unsigned long long*)(F.lds + LDS_MISC_OFF + 64); \
    const unsigned long long t_ = wall_clock64(); if ((PROBE_MASK >> ((k) % NPH_PAIR)) & 1ull) pt[1] += t_ - pt[0]; pt[0] = t_; } } while (0)
#define SEAM(k) do { if (IN(k) && IN((k) + 1)) { XcdBarrier bar; bar.bar = (unsigned*)(args.ws + WS_CTL) + CW_BAR; bar.x = xb_xcc_id(); bar.st = (volatile LAS unsigned*)(F.lds + LDS_MISC_OFF) + 8; xcd_barrier(bar); } PROBE_STAMP(k); } while (0)
#define X ((bf16_t*)(ws + WS_X))
#define H ((bf16_t*)(ws + WS_H))
#define MIX ((bf16_t*)(ws + WS_MIX))
#define P ((bf16_t*)(ws + WS_PY))
#define P2 ((bf16_t*)(ws + WS_PY + PY_P2))
#define CQN ((bf16_t*)(ws + WS_PY + PY_CQN))
#define CKVN ((bf16_t*)(ws + WS_PY + PY_CKVN))
#define Q2 ((bf16_t*)(ws + WS_PY + PY_Q2))
#define KV2 ((bf16_t*)(ws + WS_PY + PY_KV2))
#define XR ((bf16_t*)(ws + WS_PY + PY_XR))
#define Y ((float*)(ws + WS_PY + PY_Y))
#define ACT ((bf16_t*)(ws + WS_BIG))
#define DO ((bf16_t*)(ws + WS_BIG + BIG_DIL))
#define DL ((float*)(ws + WS_BIG + BIG_DIL + 48 * MiB))
#define maskT ((unsigned*)(ws + WS_MISC + MISC_MASK))
#define agg ((float*)(ws + WS_MISC + MISC_AGG))
#define rope ((const float*)(ws + WS_ROPE))
#define we ((const bf16_t*)(ws + WS_WE))
#define wo ((const bf16_t*)(ws + WS_WO))
#define PHASE_WS GAS unsigned char* ws_ = (GAS unsigned char*)args.ws; asm volatile("" : "+s"(ws_)); unsigned char* ws = (unsigned char*)ws_; F.ws = ws; { int t_ = threadIdx.x, b_ = blockIdx.x, g_ = gridDim.x; asm volatile("" : "+v"(t_), "+s"(b_), "+s"(g_)); \
    F.tid = t_; F.lane = t_ & 63; F.wave = __builtin_amdgcn_readfirstlane(t_ >> 6); F.G = g_; F.vcu = (g_ % 8 == 0) ? (b_ % 8) * (g_ / 8) + b_ / 8 : b_; F.gw = F.vcu * 8 + F.wave; F.NGW = g_ * 8; }

template <int lp> DI void pair_body(Frame& F, const Args& args) {
    constexpr int pb = lp * NPH_PAIR;
        if (IN(pb + 0)) { PHASE_WS
            if (lp == 0) { phase_cvt<false>(F, 0, 0, CE_NIT, true); phase_rope_tables(F); phase_norm<0, true>(F, F.gin(0), F.gin(1), H, nullptr); }
            else phase_norm<1, true>(F, nullptr, F.gin(1) + DM, H, nullptr);
        }
        SEAM(pb + 0);
        if (lp == 0 && args.ph_lo <= pb && pb + 1 < args.ph_hi) { PHASE_WS
            phase_requant(F, we + WE_IN / 2, (float*)(ws + WS_SB + 300 * 1024), (signed char*)(ws + WS_Q8E), EV_NP);
            { XcdBarrier bar; bar.bar = (unsigned*)(args.ws + WS_CTL) + CW_BAR; bar.x = xb_xcc_id(); bar.st = (volatile LAS unsigned*)(F.lds + LDS_MISC_OFF) + 8; xcd_barrier(bar); }
        }
        if (IN(pb + 1)) { PHASE_WS
            pg8::Gemm g{H, (const bf16_t*)(ws + WS_Q8E), DM / 2, DM / 2, 0, DM / 2, nullptr}; pg8::StaticOrder S; S.init(MTOK, EV_NP, F.G, (int)blockIdx.x);
            pg8::EpiBf16Q<1> E{P, EV_NP, rope, (const float*)(ws + WS_MISC + MISC_RT + RT_SA), (const float*)(ws + WS_SB + 300 * 1024)};
            pg8::gemm_phase<pg8::EpiBf16Q<1>, pg8::StaticOrder, true, false, true>(F.lds, g, S, E);
        }
        SEAM(pb + 1);
        if (IN(pb + 2)) { PHASE_WS
            for (int rp_ = 0; rp_ < REP_SEL; ++rp_) { const int bb = F.vcu >> 5, i = F.vcu & 31;
              bf16x8 sqf[8]; u32x4 sww;
              if (F.G == 256) { dsa_load_q(P, bb, i, F.lane, sqf, sww);
                  dsa_select_unit(F, P, maskT, bb, i, 63 - i, sqf, sww); dsa_select_unit(F, P, maskT, bb, 63 - i, 64 + i, sqf, sww); dsa_select_unit(F, P, maskT, bb, 64 + i, 127 - i, sqf, sww); dsa_select_unit(F, P, maskT, bb, 127 - i, -1, sqf, sww); }
              else for (int u = F.vcu; u < 1024; u += F.G) { dsa_load_q(P, u >> 7, u & 127, F.lane, sqf, sww); dsa_select_unit(F, P, maskT, u >> 7, u & 127, -1, sqf, sww); } }
            for (int rp_ = 0; rp_ < REP_DIL; ++rp_) for (int u = F.gw; u < 3 * 4096; u += 2 * F.NGW) dil_attn_pair(F, P, DO, DL, u, u + F.NGW);
            phase_requant(F, we + WE_GU / 2, (float*)(ws + WS_SB), (signed char*)(ws + WS_Q8D), 7168);
            phase_cvt<true>(F, lp, 0, CO_R0, true);
        }
        SEAM(pb + 2);
        if (IN(pb + 3)) { PHASE_WS
            CvtRider rd{CO_R0 + F.gw, CO_NIT, lp};
            for (int rp_ = 0; rp_ < REP_DSA; ++rp_) for (int u = F.vcu; u < 256; u += F.G) for (int rep = 0; rep < 2; ++rep) {
                const int bn = u >> 4, i = u & 15, qb = rep ? 31 - i : i, b = bn >> 1, n = bn & 1;
                const bf16_t* Pb = P + (size_t)b * SEQ * EV_NP; const int tq = 64 * qb + 32 * (F.wave & 1) + (F.lane & 31);
                block_attn_unit<1, 1>(F, rd, P, Pb + C_KA + n * 64, nullptr, Pb + C_VA + n * 64, maskT + (size_t)b * 64 * SEQ, MIX + (size_t)(b * SEQ + tq) * DM + (n * 4 + (F.wave >> 1)) * 64, b, n, qb); }
            for (; rd.it < rd.end; rd.it += F.NGW) { const CvtDesc d = cvt_odd_desc(F, lp, rd.it); f32x4 v[8]; cvt_load(d, F.lane, v); cvt_store(d, F.lane, v); }
            phase_dil_merge(F, DO, DL, MIX);
        }
        SEAM(pb + 3);
        if (IN(pb + 4)) { PHASE_WS
            pg8::Gemm g{MIX, we + WE_OUT / 2, DM, DM, 0, DM, nullptr}; pg8::StaticOrder S; S.init(MTOK, DM, F.G, (int)blockIdx.x);
            if constexpr (lp == 0) { pg8::EpiRes<true> E{X, F.gin(0)}; pg8::gemm_phase<pg8::EpiRes<true>, pg8::StaticOrder, true>(F.lds, g, S, E); }
            else { pg8::EpiRes<false> E{X, X}; pg8::gemm_phase<pg8::EpiRes<false>, pg8::StaticOrder, true>(F.lds, g, S, E); }
        }
        SEAM(pb + 4);
        if (IN(pb + 5)) { PHASE_WS phase_norm8(F, X, F.gin(4) + lp * DM, (signed char*)H, (float*)(ws + WS_MISC + MISC_RT + RT_SA));
            phase_requant(F, wo + WO_IN / 2, (float*)(ws + WS_SB + 288 * 1024), (signed char*)(ws + WS_Q8O), OD_NP); }
        SEAM(pb + 5);
        if (IN(pb + 6)) { PHASE_WS
            pg8::Gemm g{H, (const bf16_t*)(ws + WS_Q8D), DM / 2, DM / 2, 0, DM / 2, nullptr}; pg8::StaticOrder S; S.init(MTOK, 2 * DFF, F.G, (int)blockIdx.x);
            pg8::EpiSwiGLU8 E{ACT, (const float*)(ws + WS_MISC + MISC_RT + RT_SA), (const float*)(ws + WS_SB), 0};
            pg8::gemm_phase<pg8::EpiSwiGLU8, pg8::StaticOrder, true, false, true>(F.lds, g, S, E);
        }
        SEAM(pb + 6);
        if (IN(pb + 7)) { PHASE_WS
            pg8::Gemm g{ACT, we + WE_DN / 2, DFF, DFF, 0, DFF, nullptr}; pg8::StaticOrder S; S.init(MTOK, DM, F.G, (int)blockIdx.x);
            pg8::EpiRes<false> E{X, X};
            pg8::gemm_phase<pg8::EpiRes<false>, pg8::StaticOrder, true>(F.lds, g, S, E);
        }
        SEAM(pb + 7);
        if (IN(pb + 8)) { PHASE_WS phase_norm8(F, X, F.gin(8) + lp * DM, (signed char*)H, (float*)(ws + WS_MISC + MISC_RT + RT_SA)); }
        SEAM(pb + 8);
        if (IN(pb + 9)) { PHASE_WS
            pg8::Gemm g{H, (const bf16_t*)(ws + WS_Q8O), DM / 2, DM / 2, 0, DM / 2, nullptr}; pg8::StaticOrder S; S.init(MTOK, OD_NP, F.G, (int)blockIdx.x);
            pg8::EpiBf16Q<2> E{P2, OD_NP, rope, (const float*)(ws + WS_MISC + MISC_RT + RT_SA), (const float*)(ws + WS_SB + 288 * 1024)};
            pg8::gemm_phase<pg8::EpiBf16Q<2>, pg8::StaticOrder, true, false, true>(F.lds, g, S, E);
        }
        SEAM(pb + 9);
        if (IN(pb + 10)) { PHASE_WS
            phase_mla_norm(F, lp, P2, CQN, CKVN);
            for (int rp_ = 0; rp_ < REP_RG1; ++rp_) for (int u = F.gw; u < 4096; u += F.NGW) rg_unit<false>(F, lp, u >> 9, (u >> 3) & 63, u & 7, P2, wo + WO_RG / 2, agg, MIX);
            phase_requant(F, wo + WO_MGU / 2, (float*)(ws + WS_SB + 32 * 1024), (signed char*)(ws + WS_Q8M), NEXP * 7168);
            if (lp == 0) phase_cvt<false>(F, 1, 0, CE_NIT, true);
        }
        SEAM(pb + 10);
        if (IN(pb + 11)) { PHASE_WS
            if ((int)blockIdx.x >= F.G - 8) phase_rg_carry(F, agg, agg + 1024 * 1024 * 3 / 4, (int)blockIdx.x - (F.G - 8));
            { pg8::Gemm g{CQN, wo + WO_UQ / 2, 256, 256, 0, 256, nullptr}; pg8::StaticOrder S; S.init(MTOK, 768, F.G, (int)blockIdx.x);
              pg8::EpiBf16<3> E{Q2, 768, rope};
              pg8::gemm_phase<pg8::EpiBf16<3>, pg8::StaticOrder, true>(F.lds, g, S, E); }
            { pg8::Gemm g{CKVN, wo + WO_UKV / 2, 256, 256, 0, 256, nullptr}; pg8::StaticOrder S; S.init(MTOK, 1024, F.G, (int)blockIdx.x);
              pg8::EpiBf16<0> E{KV2, 1024, rope};
              pg8::gemm_phase<pg8::EpiBf16<0>, pg8::StaticOrder, true>(F.lds, g, S, E); }
        }
        SEAM(pb + 11);
        if (IN(pb + 12)) { PHASE_WS
            CvtRider rd{0, 0, 0};
            for (int rp_ = 0; rp_ < REP_MLA; ++rp_) for (int u = F.vcu; u < 256; u += F.G) for (int rep = 0; rep < 2; ++rep) {
                const int bh = u >> 2, i = u & 3, qb = rep ? 7 - i : i, b = bh >> 3, h = bh & 7;
                const bf16_t* kvb = KV2 + (size_t)b * SEQ * 1024 + h * 128; const int tq = 256 * qb + 32 * F.wave + (F.lane & 31);
                block_attn_unit<0, 0>(F, rd, Q2, kvb, P2 + (size_t)b * SEQ * OD_NP + C_KR, kvb + 64, nullptr, MIX + (size_t)(b * SEQ + tq) * DM + h * 64, b, h, qb); }
            for (int rp_ = 0; rp_ < REP_RG2; ++rp_) for (int u = F.gw; u < 4096; u += F.NGW) rg_unit<true>(F, lp, u >> 9, (u >> 3) & 63, u & 7, P2, wo + WO_RG / 2, agg, MIX);
            if (lp == 0) phase_requant(F, we + WE_IN / 2, (float*)(ws + WS_SB + 300 * 1024), (signed char*)(ws + WS_Q8E), EV_NP);
        }
        SEAM(pb + 12);
        if (IN(pb + 13)) { PHASE_WS
            pg8::Gemm g{MIX, wo + WO_OUT / 2, DM, DM, 0, DM, nullptr}; pg8::StaticOrder S; S.init(MTOK, DM, F.G, (int)blockIdx.x);
            pg8::EpiRes<false> E{X, X};
            pg8::gemm_phase<pg8::EpiRes<false>, pg8::StaticOrder, true>(F.lds, g, S, E);
        }
        SEAM(pb + 13);
        if (IN(pb + 14)) { PHASE_WS phase_norm_route(F, lp, F.gin(22) + lp * DM, H); }
        SEAM(pb + 14);
        if (IN(pb + 15)) { PHASE_WS phase_moe_scatter(F, lp); }
        SEAM(pb + 15);
        if (IN(pb + 16)) { PHASE_WS
            pg8::MoeOrder S; moe_tiles(F, lp, S.ts); S.nN = 2 * DFF / 256; S.nwg = S.ts[8] * S.nN; S.G = F.G; S.c = (int)blockIdx.x;
            const int* rtk = (const int*)(ws + WS_MISC + MISC_RT + 800 * 1024);
            pg8::Gemm g{H, (const bf16_t*)(ws + WS_Q8M), DM / 2, DM / 2, (size_t)2 * DFF * DM / 2, DM / 2, rtk};
            pg8::EpiSwiGLU8 E{ACT, (const float*)(ws + WS_MISC + MISC_RT + RT_SAG), (const float*)(ws + WS_SB + 32 * 1024), 7168};
            pg8::gemm_phase<pg8::EpiSwiGLU8, pg8::MoeOrder, true, true, true>(F.lds, g, S, E);
        }
        SEAM(pb + 16);
        if (IN(pb + 17)) { PHASE_WS
            { pg8::MoeOrder S; moe_tiles(F, lp, S.ts); const int T = S.ts[8]; (void)T; S.ts[8] = 128; S.nN = DM / 256; S.nwg = 128 * S.nN; S.G = F.G; S.c = (int)blockIdx.x;
              pg8::Gemm g{ACT, wo + WO_MDN / 2, DFF, DFF, (size_t)DM * DFF, DFF, nullptr};
              pg8::EpiBf16<0> E{(bf16_t*)Y, DM, rope};
              pg8::gemm_phase<pg8::EpiBf16<0>, pg8::MoeOrder, true>(F.lds, g, S, E); }
            { pg8::SplitOrder S; moe_tiles(F, lp, S.ts); S.nitems = (S.ts[8] - 128) * 4 * 7; S.c = (int)blockIdx.x; const int sl = S.c % 7;
              pg8::Gemm g{ACT + sl * 512, wo + WO_MDN / 2 + sl * 512, DFF, 512, (size_t)DM * DFF, DFF, nullptr};
              pg8::EpiF32 E{(float*)(ws + WS_PY + PY_XR) + (size_t)sl * 2048 * DM, nullptr, DM, 128 * 256};
              pg8::gemm_phase<pg8::EpiF32, pg8::SplitOrder, false>(F.lds, g, S, E); }
        }
        SEAM(pb + 17);
    }

__global__ void __launch_bounds__(512, 2) fwd(Args args) {
    extern __shared__ __attribute__((aligned(16))) unsigned char lds_raw[];
    Frame F;
    F.lds = (LAS unsigned char*)lds_raw; F.ws = args.ws; F.in = args.in;
    F.tid = threadIdx.x; F.lane = F.tid & 63; F.wave = __builtin_amdgcn_readfirstlane(F.tid >> 6);
    F.G = gridDim.x; { const int bx = blockIdx.x; F.vcu = (F.G % 8 == 0) ? (bx % 8) * (F.G / 8) + bx / 8 : bx; }
    F.gw = F.vcu * 8 + F.wave; F.NGW = F.G * 8;
    { volatile LAS unsigned* MISC = (volatile LAS unsigned*)(F.lds + LDS_MISC_OFF);
      for (int u = F.tid; u < (LDS_BYTES - LDS_MISC_OFF) / 4; u += 512) MISC[u] = 0u;
      __syncthreads();
      if (args.ph_hi - args.ph_lo > 1) (void)xcd_barrier_post((unsigned*)(args.ws + WS_CTL) + CW_BAR, MISC + 8); }
    if (PROBE_MASK != 0ull && blockIdx.x == 0 && threadIdx.x == 0) { volatile LAS unsigned long long* pt = (volatile LAS unsigned long long*)(F.lds + LDS_MISC_OFF + 64); pt[0] = wall_clock64(); pt[1] = 0ull; }
    pair_body<0>(F, args);
    pair_body<1>(F, args);
    if (IN(2 * NPH_PAIR)) { PHASE_WS GAS float* out_ = (GAS float*)args.out; asm volatile("" : "+s"(out_)); phase_norm<2>(F, nullptr, F.gin(27), nullptr, (float*)out_); }
    if (PROBE_MASK != 0ull && blockIdx.x == 0 && threadIdx.x == 0) { volatile LAS unsigned long long* pt = (volatile LAS unsigned long long*)(F.lds + LDS_MISC_OFF + 64); const unsigned long long t0 = wall_clock64(), w = pt[1] * PROBE_MUL; while (wall_clock64() - t0 < w) __builtin_amdgcn_s_sleep(8); }
#undef IN
#undef SEAM
}

extern "C" void kernel_launch(void* const* d_in, const int* in_sizes, int n_in, void* d_out, int out_size, void* d_ws, size_t ws_size, hipStream_t stream) {
    static int grid = 0;
    if (grid == 0) {
        if (n_in != 28 || out_size != MTOK * DM || ws_size < WS_END) { fprintf(stderr, "kernel_launch: unexpected shapes (n_in %d, out %d, ws %zu)\n", n_in, out_size, ws_size); grid = -1; return; }
        int dev = 0, cus = 0, per_cu = 0;
        if (hipGetDevice(&dev) != hipSuccess || hipDeviceGetAttribute(&cus, hipDeviceAttributeMultiprocessorCount, dev) != hipSuccess) { grid = -1; return; }
        if (hipFuncSetAttribute((const void*)fwd, hipFuncAttributeMaxDynamicSharedMemorySize, LDS_BYTES) != hipSuccess) { fprintf(stderr, "kernel_launch: hipFuncSetAttribute failed\n"); grid = -1; return; }
        if (hipOccupancyMaxActiveBlocksPerMultiprocessor(&per_cu, (const void*)fwd, 512, LDS_BYTES) != hipSuccess || per_cu < 1) fprintf(stderr, "kernel_launch: occupancy query reports %d\n", per_cu);
        (void)hipGetLastError();
        grid = cus;
    }
    if (grid < 0) return;
    (void)hipMemsetAsync((char*)d_ws + WS_CTL, 0, (size_t)(CW_BAR + XCD_BAR_WORDS) * 4, stream);
    Args a{};
    for (int i = 0; i < 28; ++i) a.in[i] = (const float*)d_in[i];
    a.out = (float*)d_out; a.ws = (unsigned char*)d_ws;
#if MK_MULTI
#ifndef MK_PHMAX
#define MK_PHMAX NPH
#endif
    for (int p = 0; p < MK_PHMAX; ++p) { a.ph_lo = p; a.ph_hi = p + 1; hipLaunchKernelGGL(fwd, dim3(grid), dim3(512), LDS_BYTES, stream, a); }
#else
    a.ph_lo = 0; a.ph_hi = NPH; hipLaunchKernelGGL(fwd, dim3(grid), dim3(512), LDS_BYTES, stream, a);
#endif
}
```

```cpp
#include <hip/hip_runtime.h>
#include <cstdio>
#include <cstdint>
#include <cmath>

#ifndef MK_MULTI
#define MK_MULTI 0
#endif

#ifndef REP_SC
#define REP_SC 1
#endif
#ifndef REP_SL
#define REP_SL 1
#endif
#ifndef REP_SEL
#define REP_SEL 1
#endif
#ifndef REP_DIL
#define REP_DIL 1
#endif
#ifndef REP_DSA
#define REP_DSA 1
#endif
#ifndef REP_MLA
#define REP_MLA 1
#endif
#ifndef REP_RG1
#define REP_RG1 1
#endif
#ifndef REP_RG2
#define REP_RG2 1
#endif
#ifndef PROBE_G
#define PROBE_G 0
#endif
#define DI __device__ __forceinline__
#define LAS __attribute__((address_space(3)))
#define GAS __attribute__((address_space(1)))
typedef unsigned short bf16_t;
typedef short bf16x8 __attribute__((ext_vector_type(8)));
typedef short s16x4 __attribute__((ext_vector_type(4)));
typedef float f32x2 __attribute__((ext_vector_type(2)));
typedef float f32x4 __attribute__((ext_vector_type(4)));
typedef float f32x16 __attribute__((ext_vector_type(16)));
typedef unsigned u32x2 __attribute__((ext_vector_type(2)));
typedef unsigned u32x4 __attribute__((ext_vector_type(4)));
typedef int i32x4 __attribute__((ext_vector_type(4)));
typedef __bf16 bf16x2_t __attribute__((ext_vector_type(2)));

constexpr int SEQ = 2048, BATCH = 8, DM = 1024, MTOK = BATCH * SEQ;
constexpr int EV_N = 2600, EV_NP = 2816;
constexpr int OD_N = 1440, OD_NP = 1536;
constexpr int DFF = 3584;
constexpr int NEXP = 8;
constexpr int MOE_ROWS = 2 * MTOK + NEXP * 256;
constexpr int C_QA = 0, C_KA = 512, C_VA = 640, C_QB = 768, C_KB = 1280, C_VB = 1792, C_QI = 2304, C_KI = 2560, C_WI = 2592;
constexpr int C_CQ = 0, C_CKV = 256, C_KR = 384, C_XR = 512, C_GR = 1024;

constexpr size_t MiB = 1u << 20;
constexpr size_t WS_CTL = 0, CTL_ZERO_BYTES = 1 * MiB;
constexpr size_t WS_ROPE = 1 * MiB;
constexpr size_t WS_WE = 2 * MiB;
constexpr size_t WE_IN = 0, WE_OUT = 6 * MiB, WE_GU = 8 * MiB, WE_DN = 23 * MiB;
constexpr size_t WS_WO = 34 * MiB;
constexpr size_t WO_IN = 0, WO_UQ = 3 * MiB, WO_UKV = 4 * MiB, WO_OUT = 5 * MiB, WO_RG = 7 * MiB, WO_MGU = 8 * MiB, WO_MDN = 120 * MiB;
constexpr size_t WS_X = 218 * MiB;
constexpr size_t WS_H = 282 * MiB;
constexpr size_t WS_MIX = 314 * MiB;
constexpr size_t WS_PY = 346 * MiB;
constexpr size_t PY_P2 = 0, PY_CQN = 48 * MiB, PY_CKVN = 56 * MiB, PY_Q2 = 64 * MiB, PY_KV2 = 88 * MiB;
constexpr size_t PY_XR = 0, PY_Y = 68 * MiB;
constexpr size_t WS_BIG = 550 * MiB;
constexpr size_t BIG_DIL = 128 * MiB;
constexpr size_t WS_MISC = 788 * MiB;
constexpr size_t MISC_MASK = 0, MISC_AGG = 4 * MiB, MISC_RT = 6 * MiB;
constexpr size_t WS_Q8M = 796 * MiB;
constexpr size_t WS_Q8D = 852 * MiB;
constexpr size_t WS_SB = 859 * MiB;
constexpr size_t WS_Q8O = 860 * MiB;
constexpr size_t WS_Q8E = 862 * MiB;
constexpr size_t WS_END = 866 * MiB;

constexpr int CW_BAR = 4096;
constexpr int CW_CNT = 64;
constexpr size_t CTL_CMAX_D = 64 * 1024, CTL_CMAX_M = 128 * 1024;
constexpr size_t RT_SAG = 1024 * 1024;
constexpr size_t RT_SA = 940 * 1024;

constexpr int LDS_MISC_OFF = 143360;
constexpr int LDS_BYTES = 147456;

DI unsigned cvtpk(float lo, float hi) { f32x2 v = {lo, hi}; bf16x2_t b = __builtin_convertvector(v, bf16x2_t); return __builtin_bit_cast(unsigned, b); }
DI float bf2f(unsigned b) { return __uint_as_float(b << 16); }
DI float bflo(unsigned w) { return __uint_as_float(w << 16); }
DI float bfhi(unsigned w) { return __uint_as_float(w & 0xffff0000u); }
DI float wave_sum(float v) {
#define WS_STEP(ctrl, rm) v += __builtin_bit_cast(float, __builtin_amdgcn_update_dpp(0, __builtin_bit_cast(int, v), ctrl, rm, 0xf, true))
    WS_STEP(0x111, 0xf); WS_STEP(0x112, 0xf); WS_STEP(0x114, 0xf); WS_STEP(0x118, 0xf); WS_STEP(0x142, 0xa); WS_STEP(0x143, 0xc);
#undef WS_STEP
    return __builtin_bit_cast(float, __builtin_amdgcn_readlane(__builtin_bit_cast(int, v), 63));
}
DI float wave_max(float v) {
#define WM_STEP(ctrl, rm) v = fmaxf(v, __builtin_bit_cast(float, __builtin_amdgcn_update_dpp(__builtin_bit_cast(int, v), __builtin_bit_cast(int, v), ctrl, rm, 0xf, false)))
    WM_STEP(0x111, 0xf); WM_STEP(0x112, 0xf); WM_STEP(0x114, 0xf); WM_STEP(0x118, 0xf); WM_STEP(0x142, 0xa); WM_STEP(0x143, 0xc);
#undef WM_STEP
    return __builtin_bit_cast(float, __builtin_amdgcn_readlane(__builtin_bit_cast(int, v), 63));
}
DI int wave_sum_i32(int v) {
    v += __builtin_amdgcn_update_dpp(0, v, 0x111, 0xf, 0xf, true);
    v += __builtin_amdgcn_update_dpp(0, v, 0x112, 0xf, 0xf, true);
    v += __builtin_amdgcn_update_dpp(0, v, 0x114, 0xf, 0xf, true);
    v += __builtin_amdgcn_update_dpp(0, v, 0x118, 0xf, 0xf, true);
    v += __builtin_amdgcn_update_dpp(0, v, 0x142, 0xa, 0xf, true);
    v += __builtin_amdgcn_update_dpp(0, v, 0x143, 0xc, 0xf, true);
    return __builtin_amdgcn_readlane(v, 63);
}
DI float xhalf_max(float v) { const auto rr = __builtin_amdgcn_permlane32_swap(__float_as_uint(v), __float_as_uint(v), false, false); return fmaxf(__uint_as_float(rr[0]), __uint_as_float(rr[1])); }
DI float xhalf_sum(float v) { const auto rr = __builtin_amdgcn_permlane32_swap(__float_as_uint(v), __float_as_uint(v), false, false); return __uint_as_float(rr[0]) + __uint_as_float(rr[1]); }
DI float tree_max16(const f32x16& s) {
    const float a0 = fmaxf(fmaxf(s[0], s[1]), s[2]), a1 = fmaxf(fmaxf(s[3], s[4]), s[5]), a2 = fmaxf(fmaxf(s[6], s[7]), s[8]), a3 = fmaxf(fmaxf(s[9], s[10]), s[11]), a4 = fmaxf(fmaxf(s[12], s[13]), s[14]);
    return fmaxf(fmaxf(fmaxf(a0, a1), a2), fmaxf(fmaxf(a3, a4), s[15]));
}
DI float tree_sum16(const f32x16& s) {
    const float a0 = s[0] + s[1], a1 = s[2] + s[3], a2 = s[4] + s[5], a3 = s[6] + s[7], a4 = s[8] + s[9], a5 = s[10] + s[11], a6 = s[12] + s[13], a7 = s[14] + s[15];
    return ((a0 + a1) + (a2 + a3)) + ((a4 + a5) + (a6 + a7));
}
DI int crow(int i, int hh) { return (i & 3) + 8 * (i >> 2) + 4 * hh; }
#define LDS_WAIT() asm volatile("s_waitcnt lgkmcnt(0)" ::: "memory")
#define VM_WAIT() asm volatile("s_waitcnt vmcnt(0)" ::: "memory")

namespace pg8 {
constexpr int BM = 256, BK = 64, HALF = 128, HTB = HALF * BK * 2, STAGE_BYTES = 8 * HTB, NXCD = 8, WGM = 4;
__host__ __device__ __forceinline__ int lds_byte(int r, int c) { const int st = (r >> 4) * 2 + (c >> 5), rr = r & 15, cc = c & 31, ob = rr * 64 + cc * 2; return st * 1024 + (ob ^ (((ob >> 9) & 1) << 5)); }
__host__ __device__ __forceinline__ void stage_rc(int b, int& R, int& C) { const int st = b / 1024, sb = b % 1024, swz = sb ^ (((sb >> 9) & 1) << 5); R = (st >> 1) * 16 + swz / 64; C = (st & 1) * 32 + (swz % 64) / 2; }
__host__ __device__ __forceinline__ int perm32(int rho) { const int n = rho >> 4, i = rho & 15; return 8 * (i >> 2) + 4 * n + (i & 3); }

struct Unit { int pm, pn, e; };
struct Gemm { const bf16_t* A; const bf16_t* Bt; int lda; int K; size_t estride; int ldb; const int* rowtok; };

__device__ __forceinline__ int xcd_remap(int L, int nwg) { const int q = nwg / NXCD, r = nwg % NXCD, xcd = L % NXCD, off = L / NXCD; return (xcd < r ? xcd * (q + 1) : r * (q + 1) + (xcd - r) * q) + off; }

struct StaticOrder {
    int nM, nN, nwg, G, c;
    __device__ void init(int M, int N, int G_, int c_) { nM = M / BM; nN = N / BM; nwg = nM * nN; G = G_; c = c_; }
    __device__ bool next(int i, Unit& u) const {
        const long L = (long)i * G + c; if (L >= nwg) return false;
        const int wgid = xcd_remap((int)L, nwg);
        const int nig = WGM * nN, gid = wgid / nig, fm = gid * WGM, gsz = (nM - fm) < WGM ? (nM - fm) : WGM;
        u.pm = fm + ((wgid % nig) % gsz); u.pn = (wgid % nig) / gsz; u.e = 0; return true;
    }
};
struct MoeOrder {
    int nN, nwg, G, c; int ts[9];
    __device__ bool next(int i, Unit& u) const {
        const long L = (long)i * G + c; if (L >= nwg) return false;
        const int wgid = xcd_remap((int)L, nwg);
        const int nig = WGM * nN, gid = wgid / nig, fm = gid * WGM, nM = ts[8], gsz = (nM - fm) < WGM ? (nM - fm) : WGM;
        u.pm = fm + ((wgid % nig) % gsz); u.pn = (wgid % nig) / gsz;
        int e = 0;
#pragma unroll
        for (int j = 1; j < 8; ++j) e += (u.pm >= ts[j]) ? 1 : 0;
        u.e = e; return true;
    }
};

struct SplitOrder {
    int nitems, c; int ts[9];
    __device__ bool next(int i, Unit& u) const {
        if (i > 0 || c >= nitems) return false;
        const int unit = c / 7; u.pm = 128 + (unit >> 2); u.pn = unit & 3;
        int e = 0;
#pragma unroll
        for (int j = 1; j < 8; ++j) e += (u.pm >= ts[j]) ? 1 : 0;
        u.e = e; return true;
    }
};

#ifndef PROBE_GATE
#define PROBE_GATE (GATHER)
#endif
template <class Epi, class Sched, bool ALIGN_EPI, bool GATHER = false, bool INT8 = false>
__device__ __forceinline__ void gemm_phase(LAS unsigned char* lds, const Gemm g, const Sched& S, const Epi& E) {
    int tid = threadIdx.x; asm volatile("" : "+v"(tid));
    const int wid = __builtin_amdgcn_readfirstlane(tid >> 6), lane = tid & 63, wr = wid >> 2, wc = wid & 3, fr = lane & 15, fq = lane >> 4;
    int K = g.K, lda = g.lda, ldb = g.ldb; asm volatile("" : "+s"(K), "+s"(lda), "+s"(ldb)); const int nt = K / BK;
    unsigned vA0[2], vA1[2], nvA0[2], nvA1[2], voffB[2]; int sR[2], sC[2];
#pragma unroll
    for (int i = 0; i < 2; ++i) { int R, C; stage_rc(tid * 16 + i * 8192, R, C); const int Rb = Epi::PERM ? ((R & ~31) + perm32(R & 31)) : R; sR[i] = R; sC[i] = C;
        vA0[i] = (unsigned)(R * lda + C) * 2u; vA1[i] = (unsigned)((R + HALF) * lda + C) * 2u; nvA0[i] = vA0[i]; nvA1[i] = vA1[i]; voffB[i] = (unsigned)(Rb * ldb + C) * 2u; }
#define PG8_GOFF(dst0, dst1, pm_) do { _Pragma("unroll") for (int _i = 0; _i < 2; ++_i) { \
        dst0[_i] = (unsigned)(g.rowtok[(pm_) * BM + sR[_i]] * lda + sC[_i]) * 2u; dst1[_i] = (unsigned)(g.rowtok[(pm_) * BM + HALF + sR[_i]] * lda + sC[_i]) * 2u; } } while (0)
    const size_t kstep = (size_t)(BK * 2);
    const size_t hstepA = (size_t)HALF * lda * 2, hstepB = (size_t)HALF * ldb * 2;
    const size_t tstepA = 2 * hstepA, tstepB = 2 * hstepB;
    const unsigned ldsw = (unsigned)wid * 1024u;
    const int aoff = lds_byte(wr * 64 + fr, fq * 8), boff = lds_byte(wc * 32 + fr, fq * 8);
#define PG8_SA(b, h) (((b) * 2 + (h)) * HTB)
#define PG8_SB(b, h) ((4 + (b) * 2 + (h)) * HTB)
#define PG8_STAGE(bufoff, gbase, voff) do { _Pragma("unroll") for (int _i = 0; _i < 2; ++_i) \
        __builtin_amdgcn_global_load_lds((const unsigned*)((const char*)(gbase) + (voff)[_i]), (LAS unsigned*)(lds + (bufoff) + ldsw + _i * 8192), 16, 0, 0); } while (0)
#define PG8_LDA(dst, b, h) do { _Pragma("unroll") for (int m = 0; m < 4; ++m) _Pragma("unroll") for (int k = 0; k < 2; ++k) dst[m][k] = *(const LAS bf16x8*)(lds + PG8_SA(b, h) + aoff + m * 2048 + k * 1024); } while (0)
#define PG8_LDB(dst, b, h) do { _Pragma("unroll") for (int n = 0; n < 2; ++n) _Pragma("unroll") for (int k = 0; k < 2; ++k) dst[n][k] = *(const LAS bf16x8*)(lds + PG8_SB(b, h) + boff + n * 2048 + k * 1024); } while (0)
#define PG8_MMA(ai, bj, At, Bt) do { __builtin_amdgcn_s_setprio(1); _Pragma("unroll") for (int m = 0; m < 4; ++m) _Pragma("unroll") for (int n = 0; n < 2; ++n) _Pragma("unroll") for (int k = 0; k < 2; ++k) \
        { if constexpr (INT8) acc[ai][bj][m][n] = __builtin_bit_cast(f32x4, __builtin_amdgcn_mfma_i32_16x16x64_i8(__builtin_bit_cast(i32x4, Bt[n][k]), __builtin_bit_cast(i32x4, At[m][k]), __builtin_bit_cast(i32x4, acc[ai][bj][m][n]), 0, 0, 0)); \
          else acc[ai][bj][m][n] = __builtin_amdgcn_mfma_f32_16x16x32_bf16(Bt[n][k], At[m][k], acc[ai][bj][m][n], 0, 0, 0); } __builtin_amdgcn_s_setprio(0); } while (0)
#define PG8_WAIT_V(n) asm volatile("s_waitcnt vmcnt(" #n ")" ::: "memory")
#define PG8_WAIT_L(n) asm volatile("s_waitcnt lgkmcnt(" #n ")" ::: "memory")
#define PG8_BAR __builtin_amdgcn_s_barrier()
#define PG8_SCHED __builtin_amdgcn_sched_barrier(0)
    LAS unsigned char* const hbase = lds + 8 * HTB; int hc = 0;
#define PG8_HDR(off, un) do { if constexpr (Epi::LDSS) E.prefetch(hbase + (off), un, wid, lane); \
        if constexpr (GATHER) { if (wid < 4) __builtin_amdgcn_global_load_lds((const unsigned*)(g.rowtok + (un).pm * BM + wid * 64 + lane), (LAS unsigned*)(hbase + (off) + 2048 + wid * 256), 4, 0, 0); } } while (0)
    Unit cur, nxt; int ui = 0;
    if (!S.next(0, cur)) return;
    f32x4 acc[2][2][4][2];
#pragma unroll
    for (int a = 0; a < 2; ++a)
#pragma unroll
        for (int b = 0; b < 2; ++b)
#pragma unroll
            for (int m = 0; m < 4; ++m)
#pragma unroll
                for (int n = 0; n < 2; ++n) acc[a][b][m][n] = (f32x4){0.f, 0.f, 0.f, 0.f};
    bf16x8 At[4][2], B0[2][2], B1[2][2];
    const char* cA = (const char*)g.A + (GATHER ? (size_t)0 : (size_t)cur.pm * tstepA); if constexpr (GATHER) PG8_GOFF(vA0, vA1, cur.pm);
    const char* cB = (const char*)g.Bt + (size_t)cur.e * g.estride * 2 + (size_t)cur.pn * tstepB;
    PG8_HDR(0, cur);
    PG8_STAGE(PG8_SB(0, 0), cB, voffB); PG8_STAGE(PG8_SB(0, 1), cB + hstepB, voffB); PG8_STAGE(PG8_SA(0, 0), cA, vA0); PG8_STAGE(PG8_SA(0, 1), cA, vA1);
    if (wr == 1) PG8_BAR;
    PG8_WAIT_V(2); PG8_BAR;
    PG8_STAGE(PG8_SB(1, 0), cB + kstep, voffB); PG8_STAGE(PG8_SA(1, 0), cA + kstep, vA0); PG8_STAGE(PG8_SB(1, 1), cB + hstepB + kstep, voffB);
    PG8_WAIT_V(6); PG8_BAR;
#if PROBE_G
    unsigned long long pg_prev = wall_clock64();
#define PG_ACC(sel) do { const unsigned long long t_ = wall_clock64(); if (PROBE_G == (sel) && PROBE_GATE && blockIdx.x == 0 && tid == 0) { volatile LAS unsigned long long* pt = (volatile LAS unsigned long long*)(lds + 143360 + 64); pt[1] += t_ - pg_prev; } pg_prev = t_; } while (0)
#else
#define PG_ACC(sel) do { } while (0)
#endif
    for (;;) {
        const bool has_next = S.next(ui + 1, nxt);
        const char* nA = has_next ? (const char*)g.A + (GATHER ? (size_t)0 : (size_t)nxt.pm * tstepA) : cA;
        const int hn = (hc == 2 * 3072) ? 0 : hc + 3072;
        if (has_next) PG8_HDR(hn, nxt);
        if constexpr (GATHER) { if (!has_next) { nvA0[0] = vA0[0]; nvA0[1] = vA0[1]; nvA1[0] = vA1[0]; nvA1[1] = vA1[1]; } } const char* nB = has_next ? (const char*)g.Bt + (size_t)nxt.e * g.estride * 2 + (size_t)nxt.pn * tstepB : cB;
        for (int t = 0; t < nt; t += 2) {
            const bool last = (t == nt - 2);
            if constexpr (GATHER) { if (last && has_next) { const LAS int* hr = (const LAS int*)(hbase + hn + 2048);
                _Pragma("unroll") for (int _i = 0; _i < 2; ++_i) { nvA0[_i] = (unsigned)(hr[sR[_i]] * lda + sC[_i]) * 2u; nvA1[_i] = (unsigned)(hr[HALF + sR[_i]] * lda + sC[_i]) * 2u; } } }
            const char* a1 = cA + (size_t)(t + 1) * kstep;
            const char* a2 = last ? nA : cA + (size_t)(t + 2) * kstep; const char* b2 = last ? nB : cB + (size_t)(t + 2) * kstep;
            const char* a3 = a2 + kstep; const char* b3 = b2 + kstep;
            unsigned sA0[2], sA1[2];
            sA0[0] = (GATHER && last) ? nvA0[0] : vA0[0]; sA0[1] = (GATHER && last) ? nvA0[1] : vA0[1]; sA1[0] = (GATHER && last) ? nvA1[0] : vA1[0]; sA1[1] = (GATHER && last) ? nvA1[1] : vA1[1];
            PG8_LDB(B0, 0, 0); PG8_LDB(B1, 0, 1); PG8_SCHED; PG8_LDA(At, 0, 0); PG8_STAGE(PG8_SA(1, 1), a1, vA1);
            PG8_WAIT_V(8); PG8_WAIT_L(0); PG8_BAR; PG8_MMA(0, 0, At, B0); PG8_MMA(0, 1, At, B1); PG8_BAR; PG8_SCHED;
            PG8_LDA(At, 0, 1); PG8_STAGE(PG8_SB(0, 0), b2, voffB); PG8_STAGE(PG8_SB(0, 1), b2 + hstepB, voffB); PG8_STAGE(PG8_SA(0, 0), a2, sA0);
            PG8_WAIT_V(8); PG8_WAIT_L(0); PG8_BAR; PG8_MMA(1, 0, At, B0); PG8_MMA(1, 1, At, B1); PG8_BAR; PG8_SCHED;
            PG8_LDB(B0, 1, 0); PG8_LDB(B1, 1, 1); PG8_SCHED; PG8_LDA(At, 1, 0); PG8_STAGE(PG8_SA(0, 1), a2, sA1);
            PG8_WAIT_V(8); PG8_WAIT_L(0); PG8_BAR; PG8_MMA(0, 0, At, B0); PG8_MMA(0, 1, At, B1); PG8_BAR; PG8_SCHED;
            PG8_LDA(At, 1, 1); PG8_STAGE(PG8_SB(1, 0), b3, voffB); PG8_STAGE(PG8_SB(1, 1), b3 + hstepB, voffB); PG8_STAGE(PG8_SA(1, 0), a3, sA0);
            PG8_WAIT_V(8); PG8_WAIT_L(0); PG8_BAR; PG8_MMA(1, 0, At, B0); PG8_MMA(1, 1, At, B1); PG8_BAR; PG8_SCHED;
        }
        PG_ACC(2);
        if constexpr (ALIGN_EPI) { if (wr == 0) PG8_BAR; }
        if constexpr (Epi::LDSS) E(acc, cur, wr, wc, fr, fq, (const LAS float*)(hbase + hc)); else E(acc, cur, wr, wc, fr, fq);
        PG_ACC(1);
        if (!has_next) break;
#pragma unroll
        for (int a = 0; a < 2; ++a)
#pragma unroll
            for (int b = 0; b < 2; ++b)
#pragma unroll
                for (int m = 0; m < 4; ++m)
#pragma unroll
                    for (int n = 0; n < 2; ++n) acc[a][b][m][n] = (f32x4){0.f, 0.f, 0.f, 0.f};
        cur = nxt; cA = nA; cB = nB; ++ui; hc = hn;
        if constexpr (GATHER) { vA0[0] = nvA0[0]; vA0[1] = nvA0[1]; vA1[0] = nvA1[0]; vA1[1] = nvA1[1]; }
        if constexpr (ALIGN_EPI) { if (wr == 1) PG8_BAR; }
    }
    PG8_WAIT_V(0);
    if constexpr (!ALIGN_EPI) { if (wr == 0) PG8_BAR; }
    PG8_BAR;
#undef PG_ACC
#undef PG8_HDR
#undef PG8_GOFF
#undef PG8_SA
#undef PG8_SB
#undef PG8_STAGE
#undef PG8_LDA
#undef PG8_LDB
#undef PG8_MMA
#undef PG8_WAIT_V
#undef PG8_WAIT_L
#undef PG8_BAR
#undef PG8_SCHED
}

template <int MODE> struct EpiBf16 {
    static constexpr bool PERM = true, LDSS = false;
    bf16_t* O; int ldc; const float* rope;
    __device__ __forceinline__ void operator()(const f32x4 (&acc)[2][2][4][2], const Unit& u, int wr, int wc, int fr, int fq) const {
        const int row0 = u.pm * BM + wr * 64 + fr;
        const float* t16 = rope; const float* t8 = rope + 2048 * 16; const float* t32 = rope + 2048 * 24;
#pragma unroll
        for (int bj = 0; bj < 2; ++bj) {
            const int gc = u.pn * BM + bj * HALF + wc * 32 + 8 * fq;
            const float* tb = nullptr; int tstride = 0, sinoff = 0;
            if (MODE == 1) {
                const bool r64 = (gc < C_VA) || (gc >= C_QB && gc < C_VB);
                if (r64 && (gc & 63) < 16) { tb = t16 + ((gc & 63) >> 3) * 4; tstride = 16; sinoff = 8; }
                else if (gc >= C_QI && gc < C_WI && (gc & 31) == 0) { tb = t8; tstride = 8; sinoff = 4; }
            } else if (MODE == 2) {
                if (gc >= C_KR && gc < C_KR + 32) { tb = t32 + ((gc - C_KR) >> 3) * 4; tstride = 32; sinoff = 16; }
            } else if (MODE == 3) {
                if (gc >= 512) { tb = t32 + ((gc & 31) >> 3) * 4; tstride = 32; sinoff = 16; }
            }
#pragma unroll
            for (int ai = 0; ai < 2; ++ai)
#pragma unroll
                for (int m = 0; m < 4; ++m) {
                    const int row = row0 + ai * HALF + m * 16;
                    f32x4 v0 = acc[ai][bj][m][0], v1 = acc[ai][bj][m][1];
                    if (MODE != 0) { if (tb) { const float* tp = tb + (size_t)(row & (SEQ - 1)) * tstride; const f32x4 c = *(const f32x4*)tp, s = *(const f32x4*)(tp + sinoff);
                        const f32x4 a = v0 * c - v1 * s, b = v0 * s + v1 * c; v0 = a; v1 = b; } }
                    u32x4 w; w.x = cvtpk(v0[0], v0[1]); w.y = cvtpk(v0[2], v0[3]); w.z = cvtpk(v1[0], v1[1]); w.w = cvtpk(v1[2], v1[3]);
                    *(u32x4*)(O + (size_t)row * ldc + gc) = w;
                }
        }
    }
};
template <int MODE> struct EpiBf16Q {
    static constexpr bool PERM = true, LDSS = true;
    bf16_t* O; int ldc; const float* rope; const float* sa; const float* wmax;
    __device__ __forceinline__ void prefetch(LAS unsigned char* hb, const Unit& u, int wid, int lane) const {
        const float* src = (wid < 4) ? sa + u.pm * BM + wid * 64 + lane : wmax + u.pn * BM + (wid - 4) * 64 + lane;
        __builtin_amdgcn_global_load_lds((const unsigned*)src, (LAS unsigned*)(hb + wid * 256), 4, 0, 0);
    }
    __device__ __forceinline__ void operator()(const f32x4 (&acc)[2][2][4][2], const Unit& u, int wr, int wc, int fr, int fq, const LAS float* hs) const {
        const int row0 = u.pm * BM + wr * 64 + fr;
        const float* t16 = rope; const float* t8 = rope + 2048 * 16; const float* t32 = rope + 2048 * 24;
#pragma unroll
        for (int bj = 0; bj < 2; ++bj) {
            const int gc = u.pn * BM + bj * HALF + wc * 32 + 8 * fq;
            const float* tb = nullptr; int tstride = 0, sinoff = 0;
            if (MODE == 1) {
                const bool r64 = (gc < C_VA) || (gc >= C_QB && gc < C_VB);
                if (r64 && (gc & 63) < 16) { tb = t16 + ((gc & 63) >> 3) * 4; tstride = 16; sinoff = 8; }
                else if (gc >= C_QI && gc < C_WI && (gc & 31) == 0) { tb = t8; tstride = 8; sinoff = 4; }
            } else if (MODE == 2) {
                if (gc >= C_KR && gc < C_KR + 32) { tb = t32 + ((gc - C_KR) >> 3) * 4; tstride = 32; sinoff = 16; }
            } else if (MODE == 3) {
                if (gc >= 512) { tb = t32 + ((gc & 31) >> 3) * 4; tstride = 32; sinoff = 16; }
            }
            const f32x4 ws0 = *(const LAS f32x4*)(hs + 256 + bj * HALF + wc * 32 + 8 * fq) * (1.0f / 127.0f), ws1 = *(const LAS f32x4*)(hs + 256 + bj * HALF + wc * 32 + 8 * fq + 4) * (1.0f / 127.0f);
#pragma unroll
            for (int ai = 0; ai < 2; ++ai)
#pragma unroll
                for (int m = 0; m < 4; ++m) {
                    const int row = row0 + ai * HALF + m * 16;
                    f32x4 v0, v1; { const i32x4 i0 = __builtin_bit_cast(i32x4, acc[ai][bj][m][0]), i1 = __builtin_bit_cast(i32x4, acc[ai][bj][m][1]); const float sr = hs[wr * 64 + fr + ai * HALF + m * 16];
                        v0 = (f32x4){(float)i0[0], (float)i0[1], (float)i0[2], (float)i0[3]} * (ws0 * sr); v1 = (f32x4){(float)i1[0], (float)i1[1], (float)i1[2], (float)i1[3]} * (ws1 * sr); }
                    if (MODE != 0) { if (tb) { const float* tp = tb + (size_t)(row & (SEQ - 1)) * tstride; const f32x4 c = *(const f32x4*)tp, s = *(const f32x4*)(tp + sinoff);
                        const f32x4 a = v0 * c - v1 * s, b = v0 * s + v1 * c; v0 = a; v1 = b; } }
                    u32x4 w; w.x = cvtpk(v0[0], v0[1]); w.y = cvtpk(v0[2], v0[3]); w.z = cvtpk(v1[0], v1[1]); w.w = cvtpk(v1[2], v1[3]);
                    *(u32x4*)(O + (size_t)row * ldc + gc) = w;
                }
        }
    }
};
template <bool BF32> struct EpiRes {
    static constexpr bool PERM = true, LDSS = false;
    bf16_t* O; const void* base;
    __device__ __forceinline__ void operator()(const f32x4 (&acc)[2][2][4][2], const Unit& u, int wr, int wc, int fr, int fq) const {
        const int row0 = u.pm * BM + wr * 64 + fr;
#pragma unroll
        for (int bj = 0; bj < 2; ++bj) {
            const int gc = u.pn * BM + bj * HALF + wc * 32 + 8 * fq;
#pragma unroll
            for (int ai = 0; ai < 2; ++ai)
#pragma unroll
                for (int m = 0; m < 4; ++m) {
                    const size_t off = (size_t)(row0 + ai * HALF + m * 16) * DM + gc;
                    f32x4 v0 = acc[ai][bj][m][0], v1 = acc[ai][bj][m][1];
                    if (BF32) { v0 += *(const f32x4*)((const float*)base + off); v1 += *(const f32x4*)((const float*)base + off + 4); }
                    else { const u32x4 b = *(const u32x4*)((const bf16_t*)base + off); v0 += (f32x4){bflo(b.x), bfhi(b.x), bflo(b.y), bfhi(b.y)}; v1 += (f32x4){bflo(b.z), bfhi(b.z), bflo(b.w), bfhi(b.w)}; }
                    u32x4 w; w.x = cvtpk(v0[0], v0[1]); w.y = cvtpk(v0[2], v0[3]); w.z = cvtpk(v1[0], v1[1]); w.w = cvtpk(v1[2], v1[3]);
                    *(u32x4*)(O + off) = w;
                }
        }
    }
};
struct EpiF32 {
    static constexpr bool PERM = false, LDSS = false;
    float* C; const float* base; int ldc; int row_sub;
    __device__ __forceinline__ void operator()(const f32x4 (&acc)[2][2][4][2], const Unit& u, int wr, int wc, int fr, int fq) const {
        const int row0 = u.pm * BM - row_sub + wr * 64 + fr, col0 = u.pn * BM + wc * 32 + 4 * fq;
#pragma unroll
        for (int ai = 0; ai < 2; ++ai)
#pragma unroll
            for (int m = 0; m < 4; ++m) { const size_t off = (size_t)(row0 + ai * HALF + m * 16) * ldc + col0;
#pragma unroll
                for (int bj = 0; bj < 2; ++bj)
#pragma unroll
                    for (int n = 0; n < 2; ++n) { f32x4 v = acc[ai][bj][m][n]; if (base) v += *(const f32x4*)(base + off + bj * HALF + n * 16); *(f32x4*)(C + off + bj * HALF + n * 16) = v; } }
    }
};
struct EpiSwiGLU {
    static constexpr bool PERM = true, LDSS = false;
    bf16_t* O;
    __device__ __forceinline__ void operator()(const f32x4 (&acc)[2][2][4][2], const Unit& u, int wr, int wc, int fr, int fq) const {
        const int row0 = u.pm * BM + wr * 64 + fr, col0 = u.pn * HALF + wc * 32 + 8 * fq;
#pragma unroll
        for (int ai = 0; ai < 2; ++ai)
#pragma unroll
            for (int m = 0; m < 4; ++m) {
                float r[8];
#pragma unroll
                for (int n = 0; n < 2; ++n)
#pragma unroll
                    for (int j = 0; j < 4; ++j) { const float gv = acc[ai][0][m][n][j], uv = acc[ai][1][m][n][j]; r[n * 4 + j] = gv * __builtin_amdgcn_rcpf(1.0f + __expf(-gv)) * uv; }
                u32x4 w; w.x = cvtpk(r[0], r[1]); w.y = cvtpk(r[2], r[3]); w.z = cvtpk(r[4], r[5]); w.w = cvtpk(r[6], r[7]);
                *(u32x4*)(O + (size_t)(row0 + ai * HALF + m * 16) * DFF + col0) = w;
            }
    }
};
struct EpiSwiGLU8 {
    static constexpr bool PERM = true, LDSS = true;
    bf16_t* O; const float* sa; const float* cmax; size_t cstride;
    __device__ __forceinline__ void prefetch(LAS unsigned char* hb, const Unit& u, int wid, int lane) const {
        const float* src = (wid < 4) ? sa + u.pm * BM + wid * 64 + lane : cmax + (size_t)u.e * cstride + u.pn * BM + (wid - 4) * 64 + lane;
        __builtin_amdgcn_global_load_lds((const unsigned*)src, (LAS unsigned*)(hb + wid * 256), 4, 0, 0);
    }
    __device__ __forceinline__ void operator()(const f32x4 (&acc)[2][2][4][2], const Unit& u, int wr, int wc, int fr, int fq, const LAS float* hs) const {
        const int row0 = u.pm * BM + wr * 64 + fr, col0 = u.pn * HALF + wc * 32 + 8 * fq;
        const LAS float* cm = hs + 256 + wc * 32 + 8 * fq;
        const f32x4 sg0 = *(const LAS f32x4*)cm * (1.0f / 127.0f), sg1 = *(const LAS f32x4*)(cm + 4) * (1.0f / 127.0f), su0 = *(const LAS f32x4*)(cm + HALF) * (1.0f / 127.0f), su1 = *(const LAS f32x4*)(cm + HALF + 4) * (1.0f / 127.0f);
#pragma unroll
        for (int ai = 0; ai < 2; ++ai)
#pragma unroll
            for (int m = 0; m < 4; ++m) {
                const int row = row0 + ai * HALF + m * 16; const float sr = hs[wr * 64 + fr + ai * HALF + m * 16];
                float r[8];
#pragma unroll
                for (int n = 0; n < 2; ++n)
#pragma unroll
                    for (int j = 0; j < 4; ++j) { const i32x4 gi = __builtin_bit_cast(i32x4, acc[ai][0][m][n]), ui = __builtin_bit_cast(i32x4, acc[ai][1][m][n]);
                        const float gv = (float)gi[j] * sr * (n ? sg1[j] : sg0[j]), uv = (float)ui[j] * sr * (n ? su1[j] : su0[j]); r[n * 4 + j] = gv * __builtin_amdgcn_rcpf(1.0f + __expf(-gv)) * uv; }
                u32x4 w; w.x = cvtpk(r[0], r[1]); w.y = cvtpk(r[2], r[3]); w.z = cvtpk(r[4], r[5]); w.w = cvtpk(r[6], r[7]);
                *(u32x4*)(O + (size_t)row * DFF + col0) = w;
            }
    }
};
}

#define XB_TMO      128
#define XB_XCNT(j)  (256  + 64 * (j))
#define XB_XSUB(j)  (1280 + 64 * (j))
#define XB_XGEN(j)  (2304 + 64 * (j))
#define XB_TOP      3328
#define XB_TOPGEN   3392
#define XCD_BAR_WORDS 3456
#define XB_SPIN_CAP (1u << 22)
DI unsigned xb_ld(unsigned* p)              { return __hip_atomic_load(p, __ATOMIC_RELAXED, __HIP_MEMORY_SCOPE_AGENT); }
DI unsigned xb_add(unsigned* p, unsigned v) { return __hip_atomic_fetch_add(p, v, __ATOMIC_RELAXED, __HIP_MEMORY_SCOPE_AGENT); }
DI unsigned xb_xcc_id() { return (unsigned)__builtin_amdgcn_s_getreg((3 << 11) | 20) & 0xFu; }
#define XB_SPIN(cond, bar) do { unsigned _sp = 0; while (cond) { __builtin_amdgcn_s_sleep(1); \
    if ((++_sp & 255u) == 0u) { if (xb_ld(&(bar)[XB_TMO])) break; if (_sp > XB_SPIN_CAP) { atomicAdd(&(bar)[XB_TMO], 1u); break; } } } } while (0)
struct XcdBarrier { unsigned* bar; unsigned x; volatile LAS unsigned* st; };
DI XcdBarrier xcd_barrier_post(unsigned* bar, volatile LAS unsigned* st) {
    XcdBarrier b; b.bar = bar; b.x = xb_xcc_id(); b.st = st;
    if (threadIdx.x == 0) (void)xb_add(&bar[XB_XCNT(b.x)], 1u);
    return b;
}
DI void xcd_barrier_complete(unsigned* bar, unsigned x, unsigned& nloc, unsigned& nx) {
    const unsigned G = gridDim.x * gridDim.y * gridDim.z;
    unsigned sum, cnt, mine, sp = 0u;
    for (;;) {
        sum = 0u; cnt = 0u; mine = 0u;
#pragma unroll
        for (unsigned j = 0; j < 16; ++j) { const unsigned c = xb_ld(&bar[XB_XCNT(j)]); sum += c; cnt += (c > 0u) ? 1u : 0u; mine = (j == x) ? c : mine; }
        if (sum == G) break;
        __builtin_amdgcn_s_sleep(1);
        if ((++sp & 255u) == 0u) { if (xb_ld(&bar[XB_TMO])) break; if (sp > XB_SPIN_CAP) { atomicAdd(&bar[XB_TMO], 1u); break; } }
    }
    nloc = mine > 0u ? mine : 1u; nx = cnt > 0u ? cnt : 1u;
}
DI void xcd_barrier(const XcdBarrier& b) {
    asm volatile("s_waitcnt vmcnt(0)" ::: "memory");
    __syncthreads();
    if (threadIdx.x == 0) {
        unsigned* bar = b.bar;
        __builtin_amdgcn_s_waitcnt(0);
        unsigned nloc = b.st[0], nx = b.st[1];
        if (nloc == 0u) { xcd_barrier_complete(bar, b.x, nloc, nx); b.st[0] = nloc; b.st[1] = nx; }
        const unsigned old = xb_add(&bar[XB_XSUB(b.x)], 1u);
        const unsigned gen = old / nloc;
        if (old + 1u == (gen + 1u) * nloc) {
            __builtin_amdgcn_fence(__ATOMIC_RELEASE, "agent");
            asm volatile("s_waitcnt vmcnt(0)" ::: "memory");
            const unsigned og = xb_add(&bar[XB_TOP], 1u);
            const unsigned tg = og / nx;
            if (og + 1u == (tg + 1u) * nx) xb_add(&bar[XB_TOPGEN], 1u);
            else XB_SPIN(xb_ld(&bar[XB_TOPGEN]) == tg, bar);
            __builtin_amdgcn_fence(__ATOMIC_ACQUIRE, "agent");
            xb_add(&bar[XB_XGEN(b.x)], 1u);
            asm volatile("s_waitcnt vmcnt(0)" ::: "memory");
        } else {
            XB_SPIN(xb_ld(&bar[XB_XGEN(b.x)]) == gen, bar);
            __builtin_amdgcn_fence(__ATOMIC_ACQUIRE, "agent");
            asm volatile("s_waitcnt vmcnt(0)" ::: "memory");
        }
    }
    __syncthreads();
}

struct Args { const float* in[28]; float* out; unsigned char* ws; int ph_lo, ph_hi; };
struct Frame {
    LAS unsigned char* lds;
    unsigned char* ws;
    const float* const* in;
    int tid, lane, wave, vcu, G, gw, NGW;
    DI const float* gin(int k) const { GAS const float* p = (GAS const float*)in[k]; asm volatile("" : "+s"(p)); return (const float*)p; }
};

DI int pd64(int d) { if (d < 16) { const int i = d & 7, part = d >> 3; return (i >> 2) * 8 + part * 4 + (i & 3); } return d; }
DI int pd32m(int d) { const int i = d & 15, part = d >> 4; return (i >> 2) * 8 + part * 4 + (i & 3); }
struct RmPlain { int off; DI int operator()(int n) const { return off + n; } };
struct RmEvenIn { DI int operator()(int n) const {
    if (n < 512) return C_QA + (n & ~63) + pd64(n & 63);
    if (n < 640) { const int m = n - 512; return C_KA + (m & ~63) + pd64(m & 63); }
    if (n < 768) return C_VA + (n - 640);
    if (n < 1024) return C_QI + (n - 768);
    if (n < 1056) return C_KI + (n - 1024);
    if (n < 1064) return C_WI + (n - 1056);
    if (n < 1576) { const int m = n - 1064; return C_QB + (m & ~63) + pd64(m & 63); }
    if (n < 2088) { const int m = n - 1576; return C_KB + (m & ~63) + pd64(m & 63); }
    return C_VB + (n - 2088); } };
struct RmGateUp { int which; DI int operator()(int n) const { return (n >> 7) * 256 + which * 128 + (n & 127); } };
struct RmOddIn { DI int operator()(int n) const {
    if (n < 256) return C_CQ + n;
    if (n < 384) return C_CKV + (n - 256);
    if (n < 416) return C_KR + pd32m(n - 384);
    if (n < 928) return C_XR + (n - 416);
    return C_GR + (n - 928); } };
struct RmUq { DI int operator()(int n) const { const int h = n / 96, d = n - h * 96; return d < 64 ? h * 64 + d : 512 + h * 32 + pd32m(d - 64); } };

struct CvtDesc { const float* W; bf16_t* WT; int N, ldk, kb, nb, kind; };
DI int cvt_row(int kind, int n) {
    if (kind == 0) return n;
    if (kind == 1) return RmEvenIn{}(n);
    if (kind == 2) return RmGateUp{0}(n);
    if (kind == 3) return RmGateUp{1}(n);
    if (kind == 4) return RmOddIn{}(n);
    return RmUq{}(n);
}
DI void cvt_load(const CvtDesc& d, int lane, f32x4 (&v)[8]) {
    const int kg = lane >> 3, n4 = lane & 7, k0 = d.kb * 64 + kg * 8, n = d.nb * 32 + n4 * 4;
    if (n < d.N) {
#pragma unroll
        for (int i = 0; i < 8; ++i) v[i] = __builtin_nontemporal_load((const f32x4*)(d.W + (size_t)(k0 + i) * d.N + n));
    }
}
DI void cvt_store(const CvtDesc& d, int lane, const f32x4 (&v)[8]) {
    const int kg = lane >> 3, n4 = lane & 7, k0 = d.kb * 64 + kg * 8, n = d.nb * 32 + n4 * 4;
    if (n < d.N) {
#pragma unroll
        for (int q = 0; q < 4; ++q) { u32x4 w; w.x = cvtpk(v[0][q], v[1][q]); w.y = cvtpk(v[2][q], v[3][q]); w.z = cvtpk(v[4][q], v[5][q]); w.w = cvtpk(v[6][q], v[7][q]);
            __builtin_nontemporal_store(w, (u32x4*)(d.WT + (size_t)cvt_row(d.kind, n + q) * d.ldk + k0)); }
    }
}
constexpr int CE_IN = 16 * 82, CE_OUT = 16 * 32, CE_G = 16 * 112, CE_D = 56 * 32, CE_NIT = CE_IN + CE_OUT + 2 * CE_G + CE_D;
DI CvtDesc cvt_even_desc(Frame& F, int li, int it) {
    bf16_t* we = (bf16_t*)(F.ws + WS_WE);
    int r = it;
    if (r < CE_IN) return CvtDesc{F.gin(2) + (size_t)li * 1024 * EV_N, we + WE_IN / 2, EV_N, 1024, r / 82, r % 82, 1}; r -= CE_IN;
    if (r < CE_OUT) return CvtDesc{F.gin(3) + (size_t)li * 1024 * 1024, we + WE_OUT / 2, 1024, 1024, r / 32, r % 32, 0}; r -= CE_OUT;
    if (r < CE_G) return CvtDesc{F.gin(5) + (size_t)li * 1024 * DFF, we + WE_GU / 2, DFF, 1024, r / 112, r % 112, 2}; r -= CE_G;
    if (r < CE_G) return CvtDesc{F.gin(6) + (size_t)li * 1024 * DFF, we + WE_GU / 2, DFF, 1024, r / 112, r % 112, 3}; r -= CE_G;
    return CvtDesc{F.gin(7) + (size_t)li * DFF * 1024, we + WE_DN / 2, 1024, DFF, r / 32, r % 32, 0};
}
DI void cvt_even_zero(Frame& F) {
    bf16_t* d_in = (bf16_t*)(F.ws + WS_WE) + WE_IN / 2;
    for (int i = F.gw * 64 + F.lane; i < (EV_NP - EV_N) * 1024 / 8; i += F.NGW * 64) *(u32x4*)(d_in + (size_t)EV_N * 1024 + (size_t)i * 8) = (u32x4){0u, 0u, 0u, 0u};
}
constexpr int CO_IN = 16 * 45, CO_UQ = 4 * 24, CO_UKV = 2 * 32, CO_OUT = 16 * 32, CO_RG = 32, CO_G = 16 * 112, CO_D = 56 * 32, CO_NIT = CO_IN + CO_UQ + CO_UKV + CO_OUT + CO_RG + NEXP * (2 * CO_G + CO_D);
DI CvtDesc cvt_odd_desc(Frame& F, int li, int it) {
    bf16_t* wo = (bf16_t*)(F.ws + WS_WO);
    int r = it;
    if (r < CO_IN) return CvtDesc{F.gin(9) + (size_t)li * 1024 * OD_N, wo + WO_IN / 2, OD_N, 1024, r / 45, r % 45, 4}; r -= CO_IN;
    if (r < CO_UQ) return CvtDesc{F.gin(11) + (size_t)li * 256 * 768, wo + WO_UQ / 2, 768, 256, r / 24, r % 24, 5}; r -= CO_UQ;
    if (r < CO_UKV) return CvtDesc{F.gin(13) + (size_t)li * 128 * 1024, wo + WO_UKV / 2, 1024, 256, r / 32, r % 32, 0}; r -= CO_UKV;
    if (r < CO_OUT) return CvtDesc{F.gin(21) + (size_t)li * 1024 * 1024, wo + WO_OUT / 2, 1024, 1024, r / 32, r % 32, 0}; r -= CO_OUT;
    if (r < CO_RG) { const int mat = r >> 1, nb = r & 1; const float* src = (mat < 8 ? F.gin(16) + (size_t)li * 8 * 4096 + mat * 4096 : F.gin(18) + (size_t)li * 8 * 4096 + (mat - 8) * 4096); return CvtDesc{src, wo + WO_RG / 2 + mat * 4096, 64, 64, 0, nb, 0}; } r -= CO_RG;
    const int e = r / (2 * CO_G + CO_D); int q = r - e * (2 * CO_G + CO_D);
    if (q < CO_G) return CvtDesc{F.gin(24) + ((size_t)li * NEXP + e) * 1024 * DFF, wo + WO_MGU / 2 + (size_t)e * 7168 * 1024, DFF, 1024, q / 112, q % 112, 2}; q -= CO_G;
    if (q < CO_G) return CvtDesc{F.gin(25) + ((size_t)li * NEXP + e) * 1024 * DFF, wo + WO_MGU / 2 + (size_t)e * 7168 * 1024, DFF, 1024, q / 112, q % 112, 3}; q -= CO_G;
    return CvtDesc{F.gin(26) + ((size_t)li * NEXP + e) * DFF * 1024, wo + WO_MDN / 2 + (size_t)e * 1024 * DFF, 1024, DFF, q / 32, q % 32, 0};
}
DI void cvt_odd_zero(Frame& F) {
    bf16_t* wo = (bf16_t*)(F.ws + WS_WO); bf16_t* d_in = wo + WO_IN / 2; bf16_t* d_ukv = wo + WO_UKV / 2;
    for (int i = F.gw * 64 + F.lane; i < 96 * 1024 / 8; i += F.NGW * 64) *(u32x4*)(d_in + (size_t)416 * 1024 + (size_t)i * 8) = (u32x4){0u, 0u, 0u, 0u};
    for (int i = F.gw * 64 + F.lane; i < 1024 * 16; i += F.NGW * 64) *(u32x4*)(d_ukv + (size_t)(i >> 4) * 256 + 128 + (i & 15) * 8) = (u32x4){0u, 0u, 0u, 0u};
}
struct CvtRider { int it, end, li; };
constexpr int CO_RIDE = 20 * 2048, CO_R0 = CO_NIT - CO_RIDE;
template <bool ODD> DI void phase_cvt(Frame& F, int li, int it_begin, int NIT, bool zero_fill) {
    int it = it_begin + F.gw;
    if (it < NIT) {
        CvtDesc d0 = ODD ? cvt_odd_desc(F, li, it) : cvt_even_desc(F, li, it), d1 = d0; f32x4 a[8], b[8];
        cvt_load(d0, F.lane, a);
        for (;;) {
            const int it1 = it + F.NGW; const bool h1 = it1 < NIT;
            if (h1) { d1 = ODD ? cvt_odd_desc(F, li, it1) : cvt_even_desc(F, li, it1); cvt_load(d1, F.lane, b); }
            cvt_store(d0, F.lane, a);
            if (!h1) break;
            const int it2 = it1 + F.NGW; const bool h2 = it2 < NIT;
            if (h2) { d0 = ODD ? cvt_odd_desc(F, li, it2) : cvt_even_desc(F, li, it2); cvt_load(d0, F.lane, a); }
            cvt_store(d1, F.lane, b);
            if (!h2) break;
            it = it2;
        }
    }
    if (zero_fill) { if (ODD) cvt_odd_zero(F); else cvt_even_zero(F); }
}
DI void phase_rope_tables(Frame& F) {
    float* t16 = (float*)(F.ws + WS_ROPE); float* t8 = t16 + 2048 * 16; float* t32 = t16 + 2048 * 24;
    const double lnth = 13.122363377404328;
    for (int i = F.gw * 64 + F.lane; i < 2048 * 28; i += F.NGW * 64) {
        const int pos = i / 28, j = i % 28; int rot, f; float* dst;
        if (j < 8) { rot = 16; f = j; dst = t16 + pos * 16 + f; } else if (j < 12) { rot = 8; f = j - 8; dst = t8 + pos * 8 + f; } else { rot = 32; f = j - 12; dst = t32 + pos * 32 + f; }
        const float invf = (float)exp(-(double)(2 * f) / (double)rot * lnth);
        const float ang = (float)pos * invf;
        dst[0] = (float)cos((double)ang); dst[rot / 2] = (float)sin((double)ang);
    }
}

template <int MODE, bool Q8 = false> DI void phase_norm(Frame& F, const float* src, const float* gain, bf16_t* H, float* outf) {
    float* sa = (float*)(F.ws + WS_MISC + MISC_RT + RT_SA);
    bf16_t* X = (bf16_t*)(F.ws + WS_X);
    const float* Y = (const float*)(F.ws + WS_PY + PY_Y);
    const int* dest = (const int*)(F.ws + WS_MISC + MISC_RT); const float* rgate = (const float*)(F.ws + WS_MISC + MISC_RT + 256 * 1024);
    f32x4 g[4];
#pragma unroll
    for (int j = 0; j < 4; ++j) g[j] = *(const f32x4*)(gain + 4 * (F.lane + 64 * j));
    for (int row = F.gw; row < MTOK; row += F.NGW) {
        f32x4 v[4]; float ss = 0.f;
#pragma unroll
        for (int j = 0; j < 4; ++j) {
            if (MODE == 0) v[j] = *(const f32x4*)(src + (size_t)row * DM + 4 * (F.lane + 64 * j));
            else { const u32x2 w = *(const u32x2*)(X + (size_t)row * DM + 4 * (F.lane + 64 * j)); v[j] = (f32x4){bflo(w.x), bfhi(w.x), bflo(w.y), bfhi(w.y)}; } }
        if (MODE != 0) {
            const int d0 = dest[row * 2], d1 = dest[row * 2 + 1]; const float g0 = rgate[row * 2], g1 = rgate[row * 2 + 1];
            const float* YP = (const float*)(F.ws + WS_PY + PY_XR);
#pragma unroll
            for (int k = 0; k < 2; ++k) { const int d = k ? d1 : d0; const float gk = k ? g1 : g0;
                if (d < 32768) { const bf16_t* y = (const bf16_t*)Y + (size_t)d * DM;
#pragma unroll
                    for (int j = 0; j < 4; ++j) { const u32x2 w = *(const u32x2*)(y + 4 * (F.lane + 64 * j)); v[j] = v[j] + (f32x4){bflo(w.x), bfhi(w.x), bflo(w.y), bfhi(w.y)} * gk; } }
                else { const float* y = YP + (size_t)(d - 32768) * DM;
#pragma unroll
                    for (int j = 0; j < 4; ++j) { f32x4 a = *(const f32x4*)(y + 4 * (F.lane + 64 * j));
#pragma unroll
                        for (int sl = 1; sl < 7; ++sl) a += *(const f32x4*)(y + (size_t)sl * 2048 * DM + 4 * (F.lane + 64 * j));
                        v[j] = v[j] + a * gk; } } }
            if (MODE == 1) {
#pragma unroll
                for (int j = 0; j < 4; ++j) { u32x2 w; w.x = cvtpk(v[j][0], v[j][1]); w.y = cvtpk(v[j][2], v[j][3]); *(u32x2*)(X + (size_t)row * DM + 4 * (F.lane + 64 * j)) = w; }
            }
        }
#pragma unroll
        for (int j = 0; j < 4; ++j) ss += (v[j][0] * v[j][0] + v[j][1] * v[j][1]) + (v[j][2] * v[j][2] + v[j][3] * v[j][3]);
        const float rstd = 1.0f / sqrtf(wave_sum(ss) * (1.0f / DM) + 1e-6f);
#pragma unroll
        for (int j = 0; j < 4; ++j) { const f32x4 y = v[j] * rstd * g[j]; v[j] = y;
            if (MODE == 2) *(f32x4*)(outf + (size_t)row * DM + 4 * (F.lane + 64 * j)) = y;
            else if (!Q8) { u32x2 w; w.x = cvtpk(y[0], y[1]); w.y = cvtpk(y[2], y[3]); *(u32x2*)(H + (size_t)row * DM + 4 * (F.lane + 64 * j)) = w; } }
        if (Q8 && MODE != 2) { float mx = 0.f;
#pragma unroll
            for (int j = 0; j < 4; ++j) mx = fmaxf(mx, fmaxf(fmaxf(fabsf(v[j][0]), fabsf(v[j][1])), fmaxf(fabsf(v[j][2]), fabsf(v[j][3]))));
            mx = wave_max(mx); const float sc = mx > 0.f ? mx * (1.0f / 127.0f) : 1.0f, inv = 1.0f / sc;
            if (F.lane == 0) sa[row] = sc;
#pragma unroll
            for (int j = 0; j < 4; ++j) { const int q0 = (int)rintf(v[j][0] * inv), q1 = (int)rintf(v[j][1] * inv), q2 = (int)rintf(v[j][2] * inv), q3 = (int)rintf(v[j][3] * inv);
                *(unsigned*)((signed char*)H + (size_t)row * DM + 4 * (F.lane + 64 * j)) = (unsigned)(q0 & 255) | ((unsigned)(q1 & 255) << 8) | ((unsigned)(q2 & 255) << 16) | ((unsigned)(q3 & 255) << 24); } }
    }
}
DI void phase_norm8(Frame& F, const bf16_t* X, const float* gain, signed char* H8, float* sa) {
    f32x4 g[4];
#pragma unroll
    for (int j = 0; j < 4; ++j) g[j] = *(const f32x4*)(gain + 4 * (F.lane + 64 * j));
    for (int row = F.gw; row < MTOK; row += F.NGW) {
        f32x4 v[4]; float ss = 0.f;
#pragma unroll
        for (int j = 0; j < 4; ++j) { const u32x2 w = *(const u32x2*)(X + (size_t)row * DM + 4 * (F.lane + 64 * j)); v[j] = (f32x4){bflo(w.x), bfhi(w.x), bflo(w.y), bfhi(w.y)}; ss += (v[j][0] * v[j][0] + v[j][1] * v[j][1]) + (v[j][2] * v[j][2] + v[j][3] * v[j][3]); }
        const float rstd = 1.0f / sqrtf(wave_sum(ss) * (1.0f / DM) + 1e-6f);
        float mx = 0.f;
#pragma unroll
        for (int j = 0; j < 4; ++j) { v[j] = v[j] * rstd * g[j]; mx = fmaxf(mx, fmaxf(fmaxf(fabsf(v[j][0]), fabsf(v[j][1])), fmaxf(fabsf(v[j][2]), fabsf(v[j][3])))); }
        mx = wave_max(mx); const float sc = mx > 0.f ? mx * (1.0f / 127.0f) : 1.0f, inv = 1.0f / sc;
        if (F.lane == 0) sa[row] = sc;
#pragma unroll
        for (int j = 0; j < 4; ++j) { const int q0 = (int)rintf(v[j][0] * inv), q1 = (int)rintf(v[j][1] * inv), q2 = (int)rintf(v[j][2] * inv), q3 = (int)rintf(v[j][3] * inv);
            *(unsigned*)(H8 + (size_t)row * DM + 4 * (F.lane + 64 * j)) = (unsigned)(q0 & 255) | ((unsigned)(q1 & 255) << 8) | ((unsigned)(q2 & 255) << 16) | ((unsigned)(q3 & 255) << 24); }
    }
}
DI void phase_requant(Frame& F, const bf16_t* Wb, float* wmax, signed char* W8, int nrows) {
    for (int row = F.gw; row < nrows; row += F.NGW) {
        const u32x4 a = __builtin_nontemporal_load((const u32x4*)(Wb + (size_t)row * 1024 + 16 * F.lane)), b = __builtin_nontemporal_load((const u32x4*)(Wb + (size_t)row * 1024 + 16 * F.lane + 8));
        const unsigned wsrc[8] = {a.x, a.y, a.z, a.w, b.x, b.y, b.z, b.w}; float mx = 0.f;
#pragma unroll
        for (int i = 0; i < 8; ++i) mx = fmaxf(mx, fmaxf(fabsf(bflo(wsrc[i])), fabsf(bfhi(wsrc[i]))));
        mx = wave_max(mx); const float inv = mx > 0.f ? 127.0f / mx : 0.f;
        if (F.lane == 0) wmax[row] = mx;
        unsigned out[4];
#pragma unroll
        for (int i = 0; i < 4; ++i) { int q[4];
#pragma unroll
            for (int k = 0; k < 2; ++k) { const unsigned w = wsrc[2 * i + k]; q[2 * k] = (int)rintf(bflo(w) * inv); q[2 * k + 1] = (int)rintf(bfhi(w) * inv); }
            out[i] = (unsigned)(q[0] & 255) | ((unsigned)(q[1] & 255) << 8) | ((unsigned)(q[2] & 255) << 16) | ((unsigned)(q[3] & 255) << 24); }
        __builtin_nontemporal_store((u32x4){out[0], out[1], out[2], out[3]}, (u32x4*)(W8 + (size_t)row * 1024 + 16 * F.lane));
    }
}
DI void phase_norm_route(Frame& F, int li, const float* gain, bf16_t* H) {
    const bf16_t* X = (const bf16_t*)(F.ws + WS_X);
    const float* R = F.gin(23) + (size_t)li * 1024 * 8;
    int* r_e = (int*)(F.ws + WS_MISC + MISC_RT + 512 * 1024); int* r_rank = r_e + 2 * MTOK; float* rgate = (float*)(F.ws + WS_MISC + MISC_RT + 256 * 1024);
    unsigned* cnt = (unsigned*)(F.ws + WS_MISC + MISC_RT + 768 * 1024);
    float* sa = (float*)(F.ws + WS_MISC + MISC_RT + RT_SA);
    LAS int* l_e = (LAS int*)F.lds; LAS int* l_rank = l_e + 128; LAS int* l_base = l_e + 256;
    f32x4 g[4]; f32x4 rt[4][4][2];
#pragma unroll
    for (int j = 0; j < 4; ++j) { g[j] = *(const f32x4*)(gain + 4 * (F.lane + 64 * j));
#pragma unroll
        for (int q = 0; q < 4; ++q) { const float* rp = R + (size_t)(4 * (F.lane + 64 * j) + q) * 8; rt[j][q][0] = *(const f32x4*)rp; rt[j][q][1] = *(const f32x4*)(rp + 4); } }
    for (int blk = F.vcu; blk < MTOK / 64; blk += F.G) {
        for (int i = 0; i < 8; ++i) {
            const int lr = F.wave * 8 + i, row = blk * 64 + lr;
            f32x4 v[4]; float ss = 0.f;
#pragma unroll
            for (int j = 0; j < 4; ++j) { const u32x2 w = *(const u32x2*)(X + (size_t)row * DM + 4 * (F.lane + 64 * j)); v[j] = (f32x4){bflo(w.x), bfhi(w.x), bflo(w.y), bfhi(w.y)}; ss += (v[j][0] * v[j][0] + v[j][1] * v[j][1]) + (v[j][2] * v[j][2] + v[j][3] * v[j][3]); }
            const float rstd = 1.0f / sqrtf(wave_sum(ss) * (1.0f / DM) + 1e-6f);
            f32x4 la = {0.f, 0.f, 0.f, 0.f}, lb = {0.f, 0.f, 0.f, 0.f};
            float amx = 0.f;
#pragma unroll
            for (int j = 0; j < 4; ++j) { const f32x4 y = v[j] * rstd * g[j]; v[j] = y; amx = fmaxf(amx, fmaxf(fmaxf(fabsf(y[0]), fabsf(y[1])), fmaxf(fabsf(y[2]), fabsf(y[3]))));
#pragma unroll
                for (int q = 0; q < 4; ++q) { la += rt[j][q][0] * y[q]; lb += rt[j][q][1] * y[q]; } }
            amx = wave_max(amx); const float qsc = amx > 0.f ? amx * (1.0f / 127.0f) : 1.0f, qinv = 1.0f / qsc;
            if (F.lane == 0) sa[row] = qsc;
#pragma unroll
            for (int j = 0; j < 4; ++j) { const int q0 = (int)rintf(v[j][0] * qinv), q1 = (int)rintf(v[j][1] * qinv), q2 = (int)rintf(v[j][2] * qinv), q3 = (int)rintf(v[j][3] * qinv);
                *(unsigned*)((signed char*)H + (size_t)row * DM + 4 * (F.lane + 64 * j)) = (unsigned)(q0 & 255) | ((unsigned)(q1 & 255) << 8) | ((unsigned)(q2 & 255) << 16) | ((unsigned)(q3 & 255) << 24); }
            float lg[8];
#pragma unroll
            for (int e = 0; e < 4; ++e) { lg[e] = wave_sum(la[e]); lg[4 + e] = wave_sum(lb[e]); }
            int e0 = 0; float v0 = lg[0];
#pragma unroll
            for (int e = 1; e < 8; ++e) if (lg[e] > v0) { v0 = lg[e]; e0 = e; }
            int e1 = (e0 == 0) ? 1 : 0; float v1 = lg[e1];
#pragma unroll
            for (int e = 1; e < 8; ++e) if (e != e0 && lg[e] > v1) { v1 = lg[e]; e1 = e; }
            const float g1 = 1.0f / (1.0f + __expf(v0 - v1)), g0 = 1.0f - g1;
            if (F.lane == 0) { l_e[lr * 2] = e0; l_e[lr * 2 + 1] = e1; rgate[row * 2] = g0; rgate[row * 2 + 1] = g1; }
        }
        __syncthreads();
        { const int e = F.wave, l = F.lane;
          const bool m0 = (l_e[l] == e), m1 = (l_e[64 + l] == e);
          const unsigned long long b0 = __ballot(m0), b1 = __ballot(m1), lt = (1ull << l) - 1ull; const int n0 = __builtin_popcountll(b0);
          if (m0) l_rank[l] = __builtin_popcountll(b0 & lt);
          if (m1) l_rank[64 + l] = n0 + __builtin_popcountll(b1 & lt);
          if (l == 0) cnt[blk * 8 + e] = (unsigned)(n0 + __builtin_popcountll(b1)); }
        __syncthreads();
        if (F.tid < 128) { const int e = l_e[F.tid]; r_e[blk * 128 + F.tid] = e; r_rank[blk * 128 + F.tid] = l_rank[F.tid]; }
        __syncthreads();
    }
}
DI void moe_tiles(Frame& F, int li, int (&ts)[9]) {
    const unsigned* tot = (const unsigned*)(F.ws + WS_MISC + MISC_RT + 784 * 1024); int acc = 0;
#pragma unroll
    for (int e = 0; e < 8; ++e) { ts[e] = acc; acc += ((int)__hip_atomic_load(&tot[e], __ATOMIC_RELAXED, __HIP_MEMORY_SCOPE_AGENT) + 255) >> 8; }
    ts[8] = acc;
}
DI void phase_moe_scatter(Frame& F, int li) {
    const unsigned* cnt = (const unsigned*)(F.ws + WS_MISC + MISC_RT + 768 * 1024);
    unsigned* tot = (unsigned*)(F.ws + WS_MISC + MISC_RT + 784 * 1024);
    LAS int* pre = (LAS int*)F.lds;
    for (int i = F.tid; i < 2048; i += 512) pre[i] = (int)cnt[i];
    __syncthreads();
    int ts[9];
    { const int e = F.wave, l = F.lane;
      const int c0 = pre[(4 * l) * 8 + e], c1 = pre[(4 * l + 1) * 8 + e], c2 = pre[(4 * l + 2) * 8 + e], c3 = pre[(4 * l + 3) * 8 + e], sm = c0 + c1 + c2 + c3;
      int inc = sm;
#pragma unroll
      for (int off = 1; off < 64; off <<= 1) { const int t = __shfl_up(inc, off); if (l >= off) inc += t; }
      const int ex = inc - sm;
      pre[(4 * l) * 8 + e] = ex; pre[(4 * l + 1) * 8 + e] = ex + c0; pre[(4 * l + 2) * 8 + e] = ex + c0 + c1; pre[(4 * l + 3) * 8 + e] = ex + c0 + c1 + c2;
      if (l == 63) { pre[2048 + e] = inc; if (blockIdx.x == 0) tot[e] = (unsigned)inc; } }
    __syncthreads();
    { int acc = 0;
#pragma unroll
      for (int e = 0; e < 8; ++e) { ts[e] = acc; acc += (pre[2048 + e] + 255) >> 8; }
      ts[8] = acc; }
    const int* r_e = (const int*)(F.ws + WS_MISC + MISC_RT + 512 * 1024); const int* r_rank = r_e + 2 * MTOK; int* dest = (int*)(F.ws + WS_MISC + MISC_RT);
    int* rowtok = (int*)(F.ws + WS_MISC + MISC_RT + 800 * 1024);
    const float* sa = (const float*)(F.ws + WS_MISC + MISC_RT + RT_SA); float* sag = (float*)(F.ws + WS_MISC + MISC_RT + RT_SAG);
    for (int idx = (int)blockIdx.x * 512 + F.tid; idx < 2 * MTOK; idx += F.G * 512) {
        const int row = idx >> 1, e = r_e[idx]; int st = 0;
#pragma unroll
        for (int j = 0; j < 8; ++j) st = (e == j) ? ts[j] : st;
        const int d = st * 256 + pre[(row >> 6) * 8 + e] + r_rank[idx];
        dest[idx] = d; rowtok[d] = row; sag[d] = sa[row];
    }
    if ((int)blockIdx.x < 8) { const int e = (int)blockIdx.x, c = pre[2048 + e], pad = ((c + 255) & ~255);
        for (int r = c + F.tid; r < pad; r += 512) { rowtok[ts[e] * 256 + r] = 0; sag[ts[e] * 256 + r] = 0.f; } }
}
typedef short v4i16_t __attribute__((ext_vector_type(4)));
constexpr int VT_STRIDE = 192, VT_BYTES = 32 * VT_STRIDE;
template <int NKS, class KL, class VL, class MK>
DI void wave_attn(const bf16x8 (&qf)[NKS], int kt_lo, int kt_hi, const KL kl, const VL vl, const MK mk, float c, LAS unsigned char* vt, int lane, f32x16 (&o)[2], float& m, float& l) {
    const int hh = lane >> 5;
    bf16x8 kn[NKS]; u32x4 vn[4];
    kl(kt_lo, kn); vl(kt_lo, vn);
    LAS unsigned char* vw = vt + (lane >> 3) * VT_STRIDE + (lane & 7) * 16;
    const LAS unsigned char* vr = vt + (4 * hh + ((lane & 15) >> 2)) * VT_STRIDE + ((lane >> 4) & 1) * 32 + (lane & 3) * 8;
    for (int kt = kt_lo; kt < kt_hi; ++kt) {
        bf16x8 kf[NKS]; u32x4 vc[4];
#pragma unroll
        for (int i = 0; i < NKS; ++i) kf[i] = kn[i];
#pragma unroll
        for (int i = 0; i < 4; ++i) vc[i] = vn[i];
        if (kt + 1 < kt_hi) { kl(kt + 1, kn); vl(kt + 1, vn); }
#pragma unroll
        for (int i = 0; i < 4; ++i) *(LAS u32x4*)(vw + i * 8 * VT_STRIDE) = vc[i];
        f32x16 s;
#pragma unroll
        for (int i = 0; i < 16; ++i) s[i] = 0.f;
#pragma unroll
        for (int ks = 0; ks < NKS; ++ks) s = __builtin_amdgcn_mfma_f32_32x32x16_bf16(kf[ks], qf[ks], s, 0, 0, 0);
        mk(kt, s);
        float mx = s[0];
#pragma unroll
        for (int i = 1; i < 16; ++i) mx = fmaxf(mx, s[i]);
        mx = fmaxf(mx, __shfl_xor(mx, 32));
        const float mnew = fmaxf(m, mx);
        const float msafe = (mnew == -INFINITY) ? 0.f : mnew;
        const float alpha = __builtin_amdgcn_exp2f((m - msafe) * c);
        float ps = 0.f;
#pragma unroll
        for (int i = 0; i < 16; ++i) { s[i] = __builtin_amdgcn_exp2f((s[i] - msafe) * c); ps += s[i]; }
        l = l * alpha + ps; m = mnew;
#pragma unroll
        for (int i = 0; i < 16; ++i) { o[0][i] *= alpha; o[1][i] *= alpha; }
        bf16x8 pf[2];
#pragma unroll
        for (int s2 = 0; s2 < 2; ++s2) { u32x4 w; w.x = cvtpk(s[8 * s2], s[8 * s2 + 1]); w.y = cvtpk(s[8 * s2 + 2], s[8 * s2 + 3]); w.z = cvtpk(s[8 * s2 + 4], s[8 * s2 + 5]); w.w = cvtpk(s[8 * s2 + 6], s[8 * s2 + 7]); pf[s2] = __builtin_bit_cast(bf16x8, w); }
        LDS_WAIT();
#pragma unroll
        for (int dt = 0; dt < 2; ++dt)
#pragma unroll
            for (int s2 = 0; s2 < 2; ++s2) {
                const v4i16_t lo = __builtin_amdgcn_ds_read_tr16_b64_v4i16((LAS v4i16_t*)(vr + (16 * s2) * VT_STRIDE + dt * 64));
                const v4i16_t hi = __builtin_amdgcn_ds_read_tr16_b64_v4i16((LAS v4i16_t*)(vr + (16 * s2 + 8) * VT_STRIDE + dt * 64));
                const bf16x8 vf = {lo[0], lo[1], lo[2], lo[3], hi[0], hi[1], hi[2], hi[3]};
                o[dt] = __builtin_amdgcn_mfma_f32_32x32x16_bf16(vf, pf[s2], o[dt], 0, 0, 0);
            }
        LDS_WAIT();
    }
}
struct KLoad4 { const bf16_t* base; size_t rs; int pos0, pstep, r, hh;
    DI void operator()(int kt, bf16x8 (&kf)[4]) const { const bf16_t* p = base + (size_t)(pos0 + pstep * (kt * 32 + r)) * rs + 8 * hh;
#pragma unroll
        for (int ks = 0; ks < 4; ++ks) kf[ks] = *(const bf16x8*)(p + 16 * ks); } };
struct KLoadMla { const bf16_t* nope; const bf16_t* rope; int r, hh;
    DI void operator()(int kt, bf16x8 (&kf)[6]) const { const int key = kt * 32 + r; const bf16_t* p = nope + (size_t)key * 1024 + 8 * hh; const bf16_t* q = rope + (size_t)key * OD_NP + 8 * hh;
#pragma unroll
        for (int ks = 0; ks < 4; ++ks) kf[ks] = *(const bf16x8*)(p + 16 * ks);
        kf[4] = *(const bf16x8*)q; kf[5] = *(const bf16x8*)(q + 16); } };
struct VLoad { const bf16_t* base; size_t rs; int pos0, pstep, lane;
    DI void operator()(int kt, u32x4 (&v)[4]) const {
#pragma unroll
        for (int i = 0; i < 4; ++i) v[i] = *(const u32x4*)(base + (size_t)(pos0 + pstep * (kt * 32 + i * 8 + (lane >> 3))) * rs + (lane & 7) * 8); } };
struct MaskCausal { int mq, hh; DI void operator()(int kt, f32x16& s) const {
#pragma unroll
        for (int i = 0; i < 16; ++i) if (kt * 32 + crow(i, hh) > mq) s[i] = -INFINITY; } };
struct MaskDil { int mq, hh, j; DI void operator()(int kt, f32x16& s) const {
        if (kt != j && kt != j - 4) return;
        const int base = mq - kt * 32 - 4 * hh;
#pragma unroll
        for (int i = 0; i < 16; ++i) { if ((unsigned)(base - ((i & 3) + 8 * (i >> 2))) > 128u) s[i] = -INFINITY; } } };
struct MaskBits { const unsigned* mrow; int hh; DI void operator()(int kt, f32x16& s) const { const unsigned w = mrow[(size_t)kt * SEQ];
#pragma unroll
        for (int i = 0; i < 16; ++i) if (!((w >> crow(i, hh)) & 1u)) s[i] = -INFINITY; } };
DI void store_o(bf16_t* orow, const f32x16 (&o)[2], float inv, int hh) {
#pragma unroll
    for (int dt = 0; dt < 2; ++dt)
#pragma unroll
        for (int g = 0; g < 4; ++g) { u32x2 w; w.x = cvtpk(o[dt][4 * g] * inv, o[dt][4 * g + 1] * inv); w.y = cvtpk(o[dt][4 * g + 2] * inv, o[dt][4 * g + 3] * inv);
            *(u32x2*)(orow + 32 * dt + 8 * g + 4 * hh) = w; }
}
constexpr float LOG2E = 1.4426950408889634f;

constexpr int SCS = 2052;
DI void dsa_load_q(const bf16_t* P, int b, int g, int lane, bf16x8 (&qf)[8], u32x4& ww) {
    const bf16_t* qrow = P + (size_t)(b * SEQ + 16 * g + (lane & 15)) * EV_NP;
#pragma unroll
    for (int h = 0; h < 8; ++h) qf[h] = *(const bf16x8*)(qrow + C_QI + h * 32 + 8 * (lane >> 4));
    ww = *(const u32x4*)(qrow + C_WI);
}
DI void dsa_select_unit(Frame& F, const bf16_t* P, unsigned* maskT, int b, int g, int gnext, bf16x8 (&qf)[8], u32x4& ww) {
    LAS float* sc = (LAS float*)F.lds;
    LAS unsigned* mst = (LAS unsigned*)(F.lds + 16 * SCS * 4);
    const int lane = F.lane, w = F.wave, qi = lane & 15, kq = lane >> 4, t0 = 16 * g;
    {
        const float wv[8] = {bflo(ww.x), bfhi(ww.x), bflo(ww.y), bfhi(ww.y), bflo(ww.z), bfhi(ww.z), bflo(ww.w), bfhi(ww.w)};
        for (int rp_ = 0; rp_ < REP_SC; ++rp_) for (int kt0 = w; kt0 <= g; kt0 += 64) {
            bf16x8 kfs[8];
#pragma unroll
            for (int j = 0; j < 8; ++j) { const int kt = kt0 + 8 * j; kfs[j] = (kt <= g) ? *(const bf16x8*)(P + (size_t)(b * SEQ + kt * 16 + qi) * EV_NP + C_KI + 8 * kq) : (bf16x8){0, 0, 0, 0, 0, 0, 0, 0}; }
#pragma unroll
            for (int j = 0; j < 8; ++j) { const int kt = kt0 + 8 * j;
                if (kt <= g) {
                    f32x4 s = {0.f, 0.f, 0.f, 0.f};
#pragma unroll
                    for (int h = 0; h < 8; ++h) { const f32x4 d = __builtin_amdgcn_mfma_f32_16x16x32_bf16(kfs[j], qf[h], (f32x4){0.f, 0.f, 0.f, 0.f}, 0, 0, 0);
#pragma unroll
                        for (int r = 0; r < 4; ++r) s[r] += wv[h] * fmaxf(d[r], 0.f); }
                    *(LAS f32x4*)(sc + qi * SCS + kt * 16 + 4 * kq) = s; } }
        }
    }
    __syncthreads();
    if (gnext >= 0) dsa_load_q(P, b, gnext, lane, qf, ww);
    for (int rp_ = 0; rp_ < REP_SL; ++rp_) for (int qq = 0; qq < 2; ++qq) {
        const int q = 2 * w + qq, t = t0 + q;
        const LAS float* srow = sc + q * SCS;
        unsigned u[32];
#pragma unroll
        for (int e = 0; e < 32; ++e) { const int s = 64 * e + lane; const unsigned bits = __float_as_uint(srow[s]); const unsigned key = (bits & 0x80000000u) ? ~bits : (bits | 0x80000000u); u[e] = (s <= t) ? key : 0u; }
        unsigned mylo = 0u, myhi = 0u;
        const int E = (t >> 6) + 1;
        if (t < 256) {
#pragma unroll
            for (int e = 0; e < 32; ++e) { const unsigned long long bal = __ballot(u[e] != 0u); if (lane == e) { mylo = (unsigned)bal; myhi = (unsigned)(bal >> 32); } }
        } else {
            unsigned T = 0u; bool exact = false;
            for (int bit = 31; bit >= 0; --bit) {
                const unsigned cand = T | (1u << bit); int cn = 0, cv = 0;
#pragma unroll
                for (int gi = 0; gi < 4; ++gi) if (gi * 8 < E) {
#pragma unroll
                    for (int e = 8 * gi; e < 8 * gi + 3; ++e) cn += __builtin_popcountll(__ballot(u[e] >= cand));
#pragma unroll
                    for (int e = 8 * gi + 3; e < 8 * gi + 8; ++e) cv += (u[e] >= cand) ? 1 : 0; }
                cn += wave_sum_i32(cv);
                if (cn >= 256) { T = cand; if (cn == 256) { exact = true; break; } }
            }
            if (exact) {
#pragma unroll
                for (int e = 0; e < 32; ++e) { const unsigned long long bal = __ballot(u[e] >= T); if (lane == e) { mylo = (unsigned)bal; myhi = (unsigned)(bal >> 32); } }
            } else {
                int cgt = 0;
#pragma unroll
                for (int e = 0; e < 32; ++e) cgt += __builtin_popcountll(__ballot(u[e] > T));
                const int need = 256 - cgt; int running = 0;
#pragma unroll
                for (int e = 0; e < 32; ++e) { const unsigned long long eq = __ballot(u[e] == T);
                    const int before = running + (int)__builtin_amdgcn_mbcnt_hi((unsigned)(eq >> 32), __builtin_amdgcn_mbcnt_lo((unsigned)eq, 0u));
                    const bool sel = (u[e] > T) || (u[e] == T && before < need);
                    const unsigned long long bal = __ballot(sel); if (lane == e) { mylo = (unsigned)bal; myhi = (unsigned)(bal >> 32); }
                    running += __builtin_popcountll(eq); }
            }
        }
        if (lane < 32) { mst[q * 64 + 2 * lane] = mylo; mst[q * 64 + 2 * lane + 1] = myhi; }
    }
    __syncthreads();
    for (int idx = F.tid; idx < 1024; idx += 512) { const int kt = idx >> 4, q = idx & 15; maskT[(size_t)(b * 64 + kt) * SEQ + t0 + q] = mst[q * 64 + kt]; }
    __syncthreads();
}
DI void dsa_attn_unit(Frame& F, const bf16_t* P, const unsigned* maskT, bf16_t* MIX, int bh, int j) {
    const int lane = F.lane, r = lane & 31, hh = lane >> 5, b = bh >> 3, hq = bh & 7, n = hq >> 2;
    const bf16_t* Pb = P + (size_t)b * SEQ * EV_NP;
    const int tq = 32 * j + r;
    bf16x8 qf[4];
#pragma unroll
    for (int ks = 0; ks < 4; ++ks) qf[ks] = *(const bf16x8*)(Pb + (size_t)tq * EV_NP + C_QA + hq * 64 + 16 * ks + 8 * hh);
    f32x16 o[2];
#pragma unroll
    for (int i = 0; i < 16; ++i) { o[0][i] = 0.f; o[1][i] = 0.f; }
    float m = -INFINITY, l = 0.f;
    wave_attn<4>(qf, 0, j + 1, KLoad4{Pb + C_KA + n * 64, (size_t)EV_NP, 0, 1, r, hh}, VLoad{Pb + C_VA + n * 64, (size_t)EV_NP, 0, 1, lane},
                 MaskBits{maskT + (size_t)b * 64 * SEQ + tq, hh}, 0.125f * LOG2E, F.lds + F.wave * VT_BYTES, lane, o, m, l);
    l += __shfl_xor(l, 32);
    store_o(MIX + (size_t)(b * SEQ + tq) * DM + hq * 64, o, 1.0f / l, hh);
}
DI void dil_attn_unit(Frame& F, const bf16_t* P, bf16_t* DO, float* DL, int br, int bh, int jt) {
    const int lane = F.lane, r = lane & 31, hh = lane >> 5, b = bh >> 3, h = bh & 7;
    const int d = (br == 0) ? 1 : (br == 1 ? 4 : 16), tpc = 64 / d, cls = jt / tpc, j = jt % tpc;
    const bf16_t* Pb = P + (size_t)b * SEQ * EV_NP;
    const int mq = 32 * j + r, tq = cls + d * mq;
    bf16x8 qf[4];
#pragma unroll
    for (int ks = 0; ks < 4; ++ks) qf[ks] = *(const bf16x8*)(Pb + (size_t)tq * EV_NP + C_QB + h * 64 + 16 * ks + 8 * hh);
    f32x16 o[2];
#pragma unroll
    for (int i = 0; i < 16; ++i) { o[0][i] = 0.f; o[1][i] = 0.f; }
    float m = -INFINITY, l = 0.f;
    wave_attn<4>(qf, (j - 4 > 0 ? j - 4 : 0), j + 1, KLoad4{Pb + C_KB + h * 64, (size_t)EV_NP, cls, d, r, hh}, VLoad{Pb + C_VB + h * 64, (size_t)EV_NP, cls, d, lane},
                 MaskDil{mq, hh, j}, 0.125f * LOG2E, F.lds + F.wave * VT_BYTES, lane, o, m, l);
    l += __shfl_xor(l, 32);
    const size_t tok = (size_t)(b * SEQ + tq);
    store_o(DO + ((size_t)br * MTOK + tok) * 512 + h * 64, o, 1.0f / l, hh);
    if (hh == 0) DL[((size_t)br * MTOK + tok) * 8 + h] = m * (0.125f * LOG2E) + __builtin_amdgcn_logf(l);
}
template <int NKS, class MK>
DI void attn_tile_step(const bf16x8 (&kf)[NKS], const u32x4 (&vc)[4], const bf16x8 (&qf)[NKS], const MK mk, int kt, float c, LAS unsigned char* vt, int lane, f32x16 (&o)[2], float& m, float& l) {
    const int hh = lane >> 5;
    LAS unsigned char* vw = vt + (lane >> 3) * VT_STRIDE + (lane & 7) * 16;
    const LAS unsigned char* vr = vt + (4 * hh + ((lane & 15) >> 2)) * VT_STRIDE + ((lane >> 4) & 1) * 32 + (lane & 3) * 8;
#pragma unroll
    for (int i = 0; i < 4; ++i) *(LAS u32x4*)(vw + i * 8 * VT_STRIDE) = vc[i];
    f32x16 s;
#pragma unroll
    for (int i = 0; i < 16; ++i) s[i] = 0.f;
#pragma unroll
    for (int ks = 0; ks < NKS; ++ks) s = __builtin_amdgcn_mfma_f32_32x32x16_bf16(kf[ks], qf[ks], s, 0, 0, 0);
    mk(kt, s);
    const float mx = xhalf_max(tree_max16(s));
    const float mnew = fmaxf(m, mx), msafe = (mnew == -INFINITY) ? 0.f : mnew, nmc = -msafe * c;
    const float alpha = __builtin_amdgcn_exp2f((m - msafe) * c);
#pragma unroll
    for (int i = 0; i < 16; ++i) s[i] = __builtin_amdgcn_exp2f(__builtin_fmaf(s[i], c, nmc));
    l = l * alpha + tree_sum16(s); m = mnew;
#pragma unroll
    for (int i = 0; i < 16; ++i) { o[0][i] *= alpha; o[1][i] *= alpha; }
    bf16x8 pf[2];
#pragma unroll
    for (int s2 = 0; s2 < 2; ++s2) { u32x4 w; w.x = cvtpk(s[8 * s2], s[8 * s2 + 1]); w.y = cvtpk(s[8 * s2 + 2], s[8 * s2 + 3]); w.z = cvtpk(s[8 * s2 + 4], s[8 * s2 + 5]); w.w = cvtpk(s[8 * s2 + 6], s[8 * s2 + 7]); pf[s2] = __builtin_bit_cast(bf16x8, w); }
    LDS_WAIT();
#pragma unroll
    for (int dt = 0; dt < 2; ++dt)
#pragma unroll
        for (int s2 = 0; s2 < 2; ++s2) {
            const v4i16_t lo = __builtin_amdgcn_ds_read_tr16_b64_v4i16((LAS v4i16_t*)(vr + (16 * s2) * VT_STRIDE + dt * 64));
            const v4i16_t hi = __builtin_amdgcn_ds_read_tr16_b64_v4i16((LAS v4i16_t*)(vr + (16 * s2 + 8) * VT_STRIDE + dt * 64));
            const bf16x8 vf = {lo[0], lo[1], lo[2], lo[3], hi[0], hi[1], hi[2], hi[3]};
            o[dt] = __builtin_amdgcn_mfma_f32_32x32x16_bf16(vf, pf[s2], o[dt], 0, 0, 0);
        }
    LDS_WAIT();
}
struct DilUnit { const bf16_t* Pb; int b, h, br, d, cls, j, mq, tq, lo, n; };
DI DilUnit dil_decode(const bf16_t* P, int u, int lane) {
    DilUnit x; const int br = u / 4096, q = u % 4096, bh = q >> 6; int jt = q & 63; jt = (jt & 1) ? 63 - (jt >> 1) : (jt >> 1);
    x.br = br; x.b = bh >> 3; x.h = bh & 7; x.d = (br == 0) ? 1 : (br == 1 ? 4 : 16); const int tpc = 64 / x.d; x.cls = jt / tpc; x.j = jt % tpc;
    x.Pb = P + (size_t)x.b * SEQ * EV_NP; x.mq = 32 * x.j + (lane & 31); x.tq = x.cls + x.d * x.mq; x.lo = (x.j - 4 > 0) ? x.j - 4 : 0; x.n = x.j + 1 - x.lo; return x;
}
DI void dil_attn_pair(Frame& F, const bf16_t* P, bf16_t* DO, float* DL, int uA, int uB) {
    const int lane = F.lane, r = lane & 31, hh = lane >> 5;
    const DilUnit A = dil_decode(P, uA, lane), B = dil_decode(P, uB, lane);
    LAS unsigned char* vtA = F.lds + F.wave * 2 * VT_BYTES; LAS unsigned char* vtB = vtA + VT_BYTES;
    bf16x8 qA[4], qB[4], kA[4], kB[4]; u32x4 vA[4], vB[4];
#pragma unroll
    for (int ks = 0; ks < 4; ++ks) { qA[ks] = *(const bf16x8*)(A.Pb + (size_t)A.tq * EV_NP + C_QB + A.h * 64 + 16 * ks + 8 * hh); qB[ks] = *(const bf16x8*)(B.Pb + (size_t)B.tq * EV_NP + C_QB + B.h * 64 + 16 * ks + 8 * hh); }
    const KLoad4 klA{A.Pb + C_KB + A.h * 64, (size_t)EV_NP, A.cls, A.d, r, hh}, klB{B.Pb + C_KB + B.h * 64, (size_t)EV_NP, B.cls, B.d, r, hh};
    const VLoad vlA{A.Pb + C_VB + A.h * 64, (size_t)EV_NP, A.cls, A.d, lane}, vlB{B.Pb + C_VB + B.h * 64, (size_t)EV_NP, B.cls, B.d, lane};
    f32x16 oA[2], oB[2];
#pragma unroll
    for (int i = 0; i < 16; ++i) { oA[0][i] = 0.f; oA[1][i] = 0.f; oB[0][i] = 0.f; oB[1][i] = 0.f; }
    float mA = -INFINITY, lA = 0.f, mB = -INFINITY, lB = 0.f;
    const float c = 0.125f * LOG2E;
    klA(A.lo, kA); vlA(A.lo, vA);
    for (int i = 0; i < 5; ++i) {
        if (i < B.n) { klB(B.lo + i, kB); vlB(B.lo + i, vB); }
        if (i < A.n) attn_tile_step<4>(kA, vA, qA, MaskDil{A.mq, hh, A.j}, A.lo + i, c, vtA, lane, oA, mA, lA);
        if (i + 1 < A.n) { klA(A.lo + i + 1, kA); vlA(A.lo + i + 1, vA); }
        if (i < B.n) attn_tile_step<4>(kB, vB, qB, MaskDil{B.mq, hh, B.j}, B.lo + i, c, vtB, lane, oB, mB, lB);
    }
    lA = xhalf_sum(lA); lB = xhalf_sum(lB);
    { const size_t tok = (size_t)(A.b * SEQ + A.tq); store_o(DO + ((size_t)A.br * MTOK + tok) * 512 + A.h * 64, oA, 1.0f / lA, hh);
      if (hh == 0) DL[((size_t)A.br * MTOK + tok) * 8 + A.h] = mA * c + __builtin_amdgcn_logf(lA); }
    { const size_t tok = (size_t)(B.b * SEQ + B.tq); store_o(DO + ((size_t)B.br * MTOK + tok) * 512 + B.h * 64, oB, 1.0f / lB, hh);
      if (hh == 0) DL[((size_t)B.br * MTOK + tok) * 8 + B.h] = mB * c + __builtin_amdgcn_logf(lB); }
}
DI void phase_dil_merge(Frame& F, const bf16_t* DO, const float* DL, bf16_t* MIX) {
    for (int idx = F.gw * 64 + F.lane; idx < MTOK * 64; idx += F.NGW * 64) {
        const int tok = idx >> 6, h = (idx >> 3) & 7, c8 = idx & 7;
        float ls[3];
#pragma unroll
        for (int br = 0; br < 3; ++br) ls[br] = DL[((size_t)br * MTOK + tok) * 8 + h];
        const float mx = fmaxf(ls[0], fmaxf(ls[1], ls[2]));
        float wgt[3], ws = 0.f;
#pragma unroll
        for (int br = 0; br < 3; ++br) { wgt[br] = __builtin_amdgcn_exp2f(ls[br] - mx); ws += wgt[br]; }
        const float inv = 1.0f / ws;
        float acc[8];
#pragma unroll
        for (int k = 0; k < 8; ++k) acc[k] = 0.f;
#pragma unroll
        for (int br = 0; br < 3; ++br) { const u32x4 v = *(const u32x4*)(DO + ((size_t)br * MTOK + tok) * 512 + h * 64 + c8 * 8); const float wq = wgt[br] * inv;
            acc[0] += wq * bflo(v.x); acc[1] += wq * bfhi(v.x); acc[2] += wq * bflo(v.y); acc[3] += wq * bfhi(v.y); acc[4] += wq * bflo(v.z); acc[5] += wq * bfhi(v.z); acc[6] += wq * bflo(v.w); acc[7] += wq * bfhi(v.w); }
        u32x4 w; w.x = cvtpk(acc[0], acc[1]); w.y = cvtpk(acc[2], acc[3]); w.z = cvtpk(acc[4], acc[5]); w.w = cvtpk(acc[6], acc[7]);
        *(u32x4*)(MIX + (size_t)tok * DM + 512 + h * 64 + c8 * 8) = w;
    }
}
DI void mla_attn_unit(Frame& F, const bf16_t* Q2, const bf16_t* KV2, const bf16_t* P2, bf16_t* MIX, int bh, int j) {
    const int lane = F.lane, r = lane & 31, hh = lane >> 5, b = bh >> 3, h = bh & 7;
    const int tq = 32 * j + r; const size_t tok = (size_t)(b * SEQ + tq);
    bf16x8 qf[6];
#pragma unroll
    for (int ks = 0; ks < 4; ++ks) qf[ks] = *(const bf16x8*)(Q2 + tok * 768 + h * 64 + 16 * ks + 8 * hh);
    qf[4] = *(const bf16x8*)(Q2 + tok * 768 + 512 + h * 32 + 8 * hh); qf[5] = *(const bf16x8*)(Q2 + tok * 768 + 512 + h * 32 + 16 + 8 * hh);
    f32x16 o[2];
#pragma unroll
    for (int i = 0; i < 16; ++i) { o[0][i] = 0.f; o[1][i] = 0.f; }
    float m = -INFINITY, l = 0.f;
    const bf16_t* kvb = KV2 + (size_t)b * SEQ * 1024 + h * 128;
    wave_attn<6>(qf, 0, j + 1, KLoadMla{kvb, P2 + (size_t)b * SEQ * OD_NP + C_KR, r, hh}, VLoad{kvb + 64, (size_t)1024, 0, 1, lane},
                 MaskCausal{tq, hh}, 0.10206207261596577f * LOG2E, F.lds + F.wave * VT_BYTES, lane, o, m, l);
    l += __shfl_xor(l, 32);
    store_o(MIX + tok * DM + h * 64, o, 1.0f / l, hh);
}
DI void phase_rg_carry(Frame& F, const float* aggp, float* hin, int blk8) {
    const int gid = blk8 * 512 + F.tid, b = gid >> 9, ch = gid & 511;
    float h = 0.f;
    for (int k0 = 0; k0 < 64; k0 += 16) {
        f32x2 ah[16];
#pragma unroll
        for (int i = 0; i < 16; ++i) ah[i] = *(const f32x2*)(aggp + ((size_t)(b * 64 + k0 + i) * 512 + ch) * 2);
#pragma unroll
        for (int i = 0; i < 16; ++i) { hin[(size_t)(b * 64 + k0 + i) * 512 + ch] = h; h = ah[i][0] * h + ah[i][1]; }
    }
}
template <int MODE, int RIDE> DI void block_attn_unit(Frame& F, CvtRider& rd, const bf16_t* Qb, const bf16_t* Kb, const bf16_t* Kr, const bf16_t* Vb, const unsigned* mrow, bf16_t* Ob, int bsel, int hsel, int qb) {
    constexpr int NKS = MODE == 0 ? 6 : 4, KS = NKS * 32 + 16, VS = 192, KBYTES = 64 * KS, STAGE = KBYTES + 64 * VS;
    constexpr size_t krs = MODE == 0 ? 1024 : EV_NP, vrs = krs;
    const int tid = F.tid, lane = F.lane, w = F.wave, r = lane & 31, hh = lane >> 5;
    const int q0w = MODE == 0 ? 256 * qb + 32 * w : 64 * qb + 32 * (w & 1);
    const int nt = MODE == 0 ? 4 * (qb + 1) : qb + 1, tw = (q0w + 31) >> 6;
    const int tq = q0w + r;
    bf16x8 qf[NKS];
    if (MODE == 0) {
        const bf16_t* qp = Qb + (size_t)(bsel * SEQ + tq) * 768;
#pragma unroll
        for (int ks = 0; ks < 4; ++ks) qf[ks] = *(const bf16x8*)(qp + hsel * 64 + 16 * ks + 8 * hh);
        qf[4] = *(const bf16x8*)(qp + 512 + hsel * 32 + 8 * hh); qf[5] = *(const bf16x8*)(qp + 512 + hsel * 32 + 16 + 8 * hh);
    } else {
        const bf16_t* qp = Qb + (size_t)(bsel * SEQ + tq) * EV_NP + C_QA + (hsel * 4 + (w >> 1)) * 64;
#pragma unroll
        for (int ks = 0; ks < 4; ++ks) qf[ks] = *(const bf16x8*)(qp + 16 * ks + 8 * hh);
    }
    const bf16_t* kg = Kb + (size_t)(tid >> 3) * krs + (tid & 7) * 8;
    const bf16_t* vg = Vb + (size_t)(tid >> 3) * vrs + (tid & 7) * 8;
    const bf16_t* rg = (MODE == 0) ? Kr + (size_t)(tid >> 2) * OD_NP + (tid & 3) * 8 : nullptr;
    LAS unsigned char* base = F.lds;
    const int kw = (tid >> 3) * KS + (tid & 7) * 16, vw = KBYTES + (tid >> 3) * VS + (tid & 7) * 16, rw = (tid >> 2) * KS + 128 + (tid & 3) * 16;
    const int ka = r * KS + 16 * hh;
    const int va = KBYTES + (4 * hh + ((lane & 15) >> 2)) * VS + ((lane >> 4) & 1) * 32 + (lane & 3) * 8;
    const float c = (MODE == 0 ? 0.10206207261596577f : 0.125f) * LOG2E;
    f32x16 o[2];
#pragma unroll
    for (int i = 0; i < 16; ++i) { o[0][i] = 0.f; o[1][i] = 0.f; }
    float m = -INFINITY, l = 0.f;
#define BA_COMPUTE \
        if (t <= tw) { \
            unsigned w0 = 0xffffffffu, w1 = 0xffffffffu; \
            if (MODE == 1) { w0 = mrow[(size_t)(2 * t) * SEQ + tq]; w1 = mrow[(size_t)(2 * t + 1) * SEQ + tq]; } \
            f32x16 s0, s1; \
        _Pragma("unroll") \
            for (int i = 0; i < 16; ++i) { s0[i] = 0.f; s1[i] = 0.f; } \
            bf16x8 ka0[NKS], ka1[NKS]; \
        _Pragma("unroll") \
            for (int ks = 0; ks < NKS; ++ks) { ka0[ks] = *(const LAS bf16x8*)(cur + ka + 32 * ks); ka1[ks] = *(const LAS bf16x8*)(cur + ka + 32 * KS + 32 * ks); } \
            asm volatile("s_waitcnt lgkmcnt(0)" ::: "memory"); __builtin_amdgcn_sched_barrier(0); \
        _Pragma("unroll") \
            for (int ks = 0; ks < NKS; ++ks) { s0 = __builtin_amdgcn_mfma_f32_32x32x16_bf16(ka0[ks], qf[ks], s0, 0, 0, 0); s1 = __builtin_amdgcn_mfma_f32_32x32x16_bf16(ka1[ks], qf[ks], s1, 0, 0, 0); } \
            if (MODE == 0) { if (64 * t + 63 > q0w) { \
        _Pragma("unroll") \
                for (int i = 0; i < 16; ++i) { const int key = 64 * t + crow(i, hh); if (key > tq) s0[i] = -INFINITY; if (key + 32 > tq) s1[i] = -INFINITY; } } } \
            else { \
        _Pragma("unroll") \
                for (int i = 0; i < 16; ++i) { const unsigned b0 = (unsigned)__builtin_amdgcn_sbfe((int)(w0 >> (4 * hh)), (i & 3) + 8 * (i >> 2), 1), b1 = (unsigned)__builtin_amdgcn_sbfe((int)(w1 >> (4 * hh)), (i & 3) + 8 * (i >> 2), 1); \
                    s0[i] = __uint_as_float((__float_as_uint(s0[i]) & b0) | (0xff800000u & ~b0)); s1[i] = __uint_as_float((__float_as_uint(s1[i]) & b1) | (0xff800000u & ~b1)); } } \
            const float mx = xhalf_max(fmaxf(tree_max16(s0), tree_max16(s1))); \
            const float mnew = fmaxf(m, mx), msafe = (mnew == -INFINITY) ? 0.f : mnew, nmc = -msafe * c; \
        _Pragma("unroll") \
            for (int i = 0; i < 16; ++i) { s0[i] = __builtin_amdgcn_exp2f(__builtin_fmaf(s0[i], c, nmc)); s1[i] = __builtin_amdgcn_exp2f(__builtin_fmaf(s1[i], c, nmc)); } \
            const float ps = tree_sum16(s0) + tree_sum16(s1); \
            if (__any(mnew != m)) { const float alpha = __builtin_amdgcn_exp2f((m - msafe) * c); l *= alpha; \
        _Pragma("unroll") \
                for (int i = 0; i < 16; ++i) { o[0][i] *= alpha; o[1][i] *= alpha; } } \
            l += ps; m = mnew; \
            bf16x8 pf[4]; \
        _Pragma("unroll") \
            for (int s2 = 0; s2 < 2; ++s2) { \
                u32x4 a; a.x = cvtpk(s0[8 * s2], s0[8 * s2 + 1]); a.y = cvtpk(s0[8 * s2 + 2], s0[8 * s2 + 3]); a.z = cvtpk(s0[8 * s2 + 4], s0[8 * s2 + 5]); a.w = cvtpk(s0[8 * s2 + 6], s0[8 * s2 + 7]); pf[s2] = __builtin_bit_cast(bf16x8, a); \
                u32x4 b; b.x = cvtpk(s1[8 * s2], s1[8 * s2 + 1]); b.y = cvtpk(s1[8 * s2 + 2], s1[8 * s2 + 3]); b.z = cvtpk(s1[8 * s2 + 4], s1[8 * s2 + 5]); b.w = cvtpk(s1[8 * s2 + 6], s1[8 * s2 + 7]); pf[2 + s2] = __builtin_bit_cast(bf16x8, b); } \
        _Pragma("unroll") \
            for (int dt = 0; dt < 2; ++dt) \
        _Pragma("unroll") \
                for (int kk = 0; kk < 4; ++kk) { \
                    const v4i16_t lo = __builtin_amdgcn_ds_read_tr16_b64_v4i16((LAS v4i16_t*)(cur + va + (16 * kk) * VS + dt * 64)); \
                    const v4i16_t hi = __builtin_amdgcn_ds_read_tr16_b64_v4i16((LAS v4i16_t*)(cur + va + (16 * kk + 8) * VS + dt * 64)); \
                    const bf16x8 vf = {lo[0], lo[1], lo[2], lo[3], hi[0], hi[1], hi[2], hi[3]}; \
                    o[dt] = __builtin_amdgcn_mfma_f32_32x32x16_bf16(vf, pf[kk], o[dt], 0, 0, 0); \
                } \
        }
    u32x4 kA, vA, rA = {0u, 0u, 0u, 0u}, kB = {0u, 0u, 0u, 0u}, vB = {0u, 0u, 0u, 0u}, rB = {0u, 0u, 0u, 0u};
#define BA_LOAD(K_, V_, R_, tt) do { K_ = *(const u32x4*)(kg + (size_t)(tt) * 64 * krs); V_ = *(const u32x4*)(vg + (size_t)(tt) * 64 * vrs); if (MODE == 0 && tid < 256) R_ = *(const u32x4*)(rg + (size_t)(tt) * 64 * OD_NP); } while (0)
#define BA_WRITE(K_, V_, R_, dst) do { *(LAS u32x4*)((dst) + kw) = K_; *(LAS u32x4*)((dst) + vw) = V_; if (MODE == 0 && tid < 256) *(LAS u32x4*)((dst) + rw) = R_; } while (0)
    BA_LOAD(kA, vA, rA, 0);
    BA_WRITE(kA, vA, rA, base);
    if (nt > 1) BA_LOAD(kA, vA, rA, 1);
    __syncthreads();
#define BA_ITER(KX, VX, RX, KY, VY, RY) do { \
        const LAS unsigned char* cur = base + (t & 1) * STAGE; LAS unsigned char* nxt = base + ((t + 1) & 1) * STAGE; \
        if (t + 2 < nt) BA_LOAD(KY, VY, RY, t + 2); \
        CvtDesc rdd{}; f32x4 rdv[8]; bool rdh = false; \
        if (RIDE != 0) { rdh = rd.it < rd.end; if (rdh) { rdd = (RIDE == 1) ? cvt_odd_desc(F, rd.li, rd.it) : cvt_even_desc(F, rd.li, rd.it); cvt_load(rdd, lane, rdv); } } \
        BA_COMPUTE \
        if (RIDE != 0) { if (rdh) { cvt_store(rdd, lane, rdv); rd.it += F.NGW; } } \
        if (t + 1 < nt) BA_WRITE(KX, VX, RX, nxt); \
        __syncthreads(); } while (0)
    for (int t = 0; t < nt; t += 2) {
        BA_ITER(kA, vA, rA, kB, vB, rB);
        ++t; if (t < nt) BA_ITER(kB, vB, rB, kA, vA, rA);
        --t;
    }
#undef BA_ITER
#undef BA_LOAD
#undef BA_WRITE
#undef BA_COMPUTE
    l = xhalf_sum(l);
    store_o(Ob, o, 1.0f / l, hh);
}
DI void phase_mla_norm(Frame& F, int li, const bf16_t* P2, bf16_t* CQN, bf16_t* CKVN) {
    const float* gq = F.gin(10) + li * 256; const float* gkv = F.gin(12) + li * 128;
    const f32x4 g4 = *(const f32x4*)(gq + 4 * F.lane); const f32x2 g2 = *(const f32x2*)(gkv + 2 * F.lane);
    for (int row = F.gw; row < MTOK; row += F.NGW) {
        const u32x2 a = *(const u32x2*)(P2 + (size_t)row * OD_NP + C_CQ + 4 * F.lane); const unsigned kv = *(const unsigned*)(P2 + (size_t)row * OD_NP + C_CKV + 2 * F.lane);
        const float q0 = bflo(a.x), q1 = bfhi(a.x), q2 = bflo(a.y), q3 = bfhi(a.y), k0 = bflo(kv), k1 = bfhi(kv);
        const float sq = wave_sum(q0 * q0 + q1 * q1 + q2 * q2 + q3 * q3), sk = wave_sum(k0 * k0 + k1 * k1);
        const float rq = 1.0f / sqrtf(sq * (1.0f / 256.0f) + 1e-6f), rk = 1.0f / sqrtf(sk * (1.0f / 128.0f) + 1e-6f);
        u32x2 w; w.x = cvtpk(q0 * rq * g4[0], q1 * rq * g4[1]); w.y = cvtpk(q2 * rq * g4[2], q3 * rq * g4[3]);
        *(u32x2*)(CQN + (size_t)row * 256 + 4 * F.lane) = w;
        *(unsigned*)(CKVN + (size_t)row * 256 + 2 * F.lane) = cvtpk(k0 * rk * g2[0], k1 * rk * g2[1]);
        *(unsigned*)(CKVN + (size_t)row * 256 + 128 + 2 * F.lane) = 0u;
    }
}
constexpr int XS_STRIDE = 68, XS_BYTES = 32 * XS_STRIDE * 4;
template <bool FINAL> DI void rg_unit(Frame& F, int li, int b, int k, int n, const bf16_t* P2, const bf16_t* wt, float* agg, bf16_t* MIX) {
    const int lane = F.lane, r = lane & 31, hh = lane >> 5, t0 = 32 * k, row0 = b * SEQ + t0;
    LAS float* xs = (LAS float*)(F.lds + 65536 + F.wave * XS_BYTES);
    const float* cw = F.gin(14) + li * 4 * 512; const float* cb = F.gin(15) + li * 512; const float* ba = F.gin(17) + li * 512; const float* bx = F.gin(19) + li * 512; const float* lam = F.gin(20) + li * 512;
    float gpre[2][16], hpre[2] = {0.f, 0.f};
    if (FINAL) {
#pragma unroll
        for (int jn = 0; jn < 2; ++jn) { const int ch = n * 64 + jn * 32 + r; hpre[jn] = agg[(size_t)1024 * 1024 * 3 / 4 + (size_t)(b * 64 + k) * 512 + ch];
#pragma unroll
            for (int i = 0; i < 16; ++i) gpre[jn][i] = bf2f(P2[(size_t)(row0 + crow(i, hh)) * OD_NP + C_GR + ch]); }
    }
    bf16x8 af[4];
#pragma unroll
    for (int ks = 0; ks < 4; ++ks) {
        const int ch = n * 64 + 16 * ks + 8 * hh;
        float xc[8]; { const f32x4 c0 = *(const f32x4*)(cb + ch), c1 = *(const f32x4*)(cb + ch + 4); xc[0] = c0[0]; xc[1] = c0[1]; xc[2] = c0[2]; xc[3] = c0[3]; xc[4] = c1[0]; xc[5] = c1[1]; xc[6] = c1[2]; xc[7] = c1[3]; }
#pragma unroll
        for (int w = 0; w < 4; ++w) { const int tt = t0 + r - 3 + w;
            if (tt >= 0) { const u32x4 xv = *(const u32x4*)(P2 + (size_t)(b * SEQ + tt) * OD_NP + C_XR + ch); const f32x4 w0 = *(const f32x4*)(cw + w * 512 + ch), w1 = *(const f32x4*)(cw + w * 512 + ch + 4);
                xc[0] += w0[0] * bflo(xv.x); xc[1] += w0[1] * bfhi(xv.x); xc[2] += w0[2] * bflo(xv.y); xc[3] += w0[3] * bfhi(xv.y); xc[4] += w1[0] * bflo(xv.z); xc[5] += w1[1] * bfhi(xv.z); xc[6] += w1[2] * bflo(xv.w); xc[7] += w1[3] * bfhi(xv.w); } }
        u32x4 w; w.x = cvtpk(xc[0], xc[1]); w.y = cvtpk(xc[2], xc[3]); w.z = cvtpk(xc[4], xc[5]); w.w = cvtpk(xc[6], xc[7]); af[ks] = __builtin_bit_cast(bf16x8, w);
        *(LAS f32x4*)(xs + r * XS_STRIDE + 16 * ks + 8 * hh) = (f32x4){xc[0], xc[1], xc[2], xc[3]}; *(LAS f32x4*)(xs + r * XS_STRIDE + 16 * ks + 8 * hh + 4) = (f32x4){xc[4], xc[5], xc[6], xc[7]};
    }
    LDS_WAIT();
#pragma unroll
    for (int jn = 0; jn < 2; ++jn) {
        f32x16 da, dx;
#pragma unroll
        for (int i = 0; i < 16; ++i) { da[i] = 0.f; dx[i] = 0.f; }
#pragma unroll
        for (int ks = 0; ks < 4; ++ks) { const bf16x8 wa = *(const bf16x8*)(wt + (size_t)((n * 64 + jn * 32 + r) * 64) + 16 * ks + 8 * hh), wx = *(const bf16x8*)(wt + (size_t)(((8 + n) * 64 + jn * 32 + r) * 64) + 16 * ks + 8 * hh);
            da = __builtin_amdgcn_mfma_f32_32x32x16_bf16(af[ks], wa, da, 0, 0, 0); dx = __builtin_amdgcn_mfma_f32_32x32x16_bf16(af[ks], wx, dx, 0, 0, 0); }
        const int ch = n * 64 + jn * 32 + r;
        const float cl = -8.0f * log1pf(__expf(-lam[ch])), bav = ba[ch], bxv = bx[ch];
        float a[16], u[16];
#pragma unroll
        for (int i = 0; i < 16; ++i) { const int tok = crow(i, hh);
            const float rr = __builtin_amdgcn_rcpf(1.0f + __expf(-(da[i] + bav))), ig = __builtin_amdgcn_rcpf(1.0f + __expf(-(dx[i] + bxv))), xcv = xs[tok * XS_STRIDE + jn * 32 + r];
            const float la = cl * rr; a[i] = __expf(la); u[i] = __builtin_amdgcn_sqrtf(fmaxf((1.0f - a[i]) * (1.0f + a[i]), 0.f)) * (ig * xcv); }
        float Ag[4], Hg[4];
#pragma unroll
        for (int g = 0; g < 4; ++g) { float A = 1.f, H = 0.f;
#pragma unroll
            for (int e = 0; e < 4; ++e) { A *= a[4 * g + e]; H = a[4 * g + e] * H + u[4 * g + e]; } Ag[g] = A; Hg[g] = H; }
        float hin = 0.f;
        if (FINAL) hin = hpre[jn];
        float S = hin, Aall = 1.f, st[4];
#pragma unroll
        for (int g = 0; g < 4; ++g) { const float pA = __shfl_xor(Ag[g], 32), pH = __shfl_xor(Hg[g], 32);
            const float A0 = hh ? pA : Ag[g], H0 = hh ? pH : Hg[g], A1 = hh ? Ag[g] : pA, H1 = hh ? Hg[g] : pH;
            const float s0 = S; S = A0 * S + H0; const float s1 = S; S = A1 * S + H1; Aall *= A0 * A1; st[g] = hh ? s1 : s0; }
        if (!FINAL) { if (hh == 0) *(f32x2*)(agg + ((size_t)(b * 64 + k) * 512 + ch) * 2) = (f32x2){Aall, S}; }
        else {
#pragma unroll
            for (int g = 0; g < 4; ++g) { float hcur = st[g];
#pragma unroll
                for (int e = 0; e < 4; ++e) { const int i = 4 * g + e, tok = crow(i, hh); hcur = a[i] * hcur + u[i];
                    const float gt = gpre[jn][i];
                    const float y = 0.7978845608028654f * (gt + 0.044715f * gt * gt * gt), th = 1.0f - 2.0f * __builtin_amdgcn_rcpf(1.0f + __expf(2.0f * y)), ge = 0.5f * gt * (1.0f + th);
                    MIX[(size_t)(row0 + tok) * DM + 512 + ch] = (bf16_t)(cvtpk(hcur * ge, 0.f) & 0xffffu); } }
        }
    }
    LDS_WAIT();
}

constexpr int NPH_PAIR = 18, NPH = 2 * NPH_PAIR + 1;
#ifndef PH_EN
#define PH_EN 0x3ffffull
#endif
#define IN(k) ((((PH_EN) >> (((k) >= 2 * NPH_PAIR) ? 0 : ((k) % NPH_PAIR))) & 1ull) && args.ph_lo <= (k) && (k) < args.ph_hi)
#ifndef PROBE_MASK
#define PROBE_MASK 0ull
#endif
#ifndef PROBE_MUL
#define PROBE_MUL 2
#endif
#define PROBE_STAMP(k) do { if (PROBE_MASK != 0ull && blockIdx.x == 0 && threadIdx.x == 0) { volatile LAS unsigned long long* pt = (volatile LAS unsigned long long*)(F.lds + LDS_MISC_OFF + 64); \
    const unsigned long long t_ = wall_clock64(); if ((PROBE_MASK >> ((k) % NPH_PAIR)) & 1ull) pt[1] += t_ - pt[0]; pt[0] = t_; } } while (0)
#define SEAM(k) do { if (IN(k) && IN((k) + 1)) { XcdBarrier bar; bar.bar = (unsigned*)(args.ws + WS_CTL) + CW_BAR; bar.x = xb_xcc_id(); bar.st = (volatile LAS unsigned*)(F.lds + LDS_MISC_OFF) + 8; xcd_barrier(bar); } PROBE_STAMP(k); } while (0)
#define X ((bf16_t*)(ws + WS_X))
#define H ((bf16_t*)(ws + WS_H))
#define MIX ((bf16_t*)(ws + WS_MIX))
#define P ((bf16_t*)(ws + WS_PY))
#define P2 ((bf16_t*)(ws + WS_PY + PY_P2))
#define CQN ((bf16_t*)(ws + WS_PY + PY_CQN))
#define CKVN ((bf16_t*)(ws + WS_PY + PY_CKVN))
#define Q2 ((bf16_t*)(ws + WS_PY + PY_Q2))
#define KV2 ((bf16_t*)(ws + WS_PY + PY_KV2))
#define XR ((bf16_t*)(ws + WS_PY + PY_XR))
#define Y ((float*)(ws + WS_PY + PY_Y))
#define ACT ((bf16_t*)(ws + WS_BIG))
#define DO ((bf16_t*)(ws + WS_BIG + BIG_DIL))
#define DL ((float*)(ws + WS_BIG + BIG_DIL + 48 * MiB))
#define maskT ((unsigned*)(ws + WS_MISC + MISC_MASK))
#define agg ((float*)(ws + WS_MISC + MISC_AGG))
#define rope ((const float*)(ws + WS_ROPE))
#define we ((const bf16_t*)(ws + WS_WE))
#define wo ((const bf16_t*)(ws + WS_WO))
#define PHASE_WS GAS unsigned char* ws_ = (GAS unsigned char*)args.ws; asm volatile("" : "+s"(ws_)); unsigned char* ws = (unsigned char*)ws_; F.ws = ws; { int t_ = threadIdx.x, b_ = blockIdx.x, g_ = gridDim.x; asm volatile("" : "+v"(t_), "+s"(b_), "+s"(g_)); \
    F.tid = t_; F.lane = t_ & 63; F.wave = __builtin_amdgcn_readfirstlane(t_ >> 6); F.G = g_; F.vcu = (g_ % 8 == 0) ? (b_ % 8) * (g_ / 8) + b_ / 8 : b_; F.gw = F.vcu * 8 + F.wave; F.NGW = g_ * 8; }

template <int lp> DI void pair_body(Frame& F, const Args& args) {
    constexpr int pb = lp * NPH_PAIR;
        if (IN(pb + 0)) { PHASE_WS
            if (lp == 0) { phase_cvt<false>(F, 0, 0, CE_NIT, true); phase_rope_tables(F); phase_norm<0, true>(F, F.gin(0), F.gin(1), H, nullptr); }
            else phase_norm<1, true>(F, nullptr, F.gin(1) + DM, H, nullptr);
        }
        SEAM(pb + 0);
        if (lp == 0 && args.ph_lo <= pb && pb + 1 < args.ph_hi) { PHASE_WS
            phase_requant(F, we + WE_IN / 2, (float*)(ws + WS_SB + 300 * 1024), (signed char*)(ws + WS_Q8E), EV_NP);
            { XcdBarrier bar; bar.bar = (unsigned*)(args.ws + WS_CTL) + CW_BAR; bar.x = xb_xcc_id(); bar.st = (volatile LAS unsigned*)(F.lds + LDS_MISC_OFF) + 8; xcd_barrier(bar); }
        }
        if (IN(pb + 1)) { PHASE_WS
            pg8::Gemm g{H, (const bf16_t*)(ws + WS_Q8E), DM / 2, DM / 2, 0, DM / 2, nullptr}; pg8::StaticOrder S; S.init(MTOK, EV_NP, F.G, (int)blockIdx.x);
            pg8::EpiBf16Q<1> E{P, EV_NP, rope, (const float*)(ws + WS_MISC + MISC_RT + RT_SA), (const float*)(ws + WS_SB + 300 * 1024)};
            pg8::gemm_phase<pg8::EpiBf16Q<1>, pg8::StaticOrder, true, false, true>(F.lds, g, S, E);
        }
        SEAM(pb + 1);
        if (IN(pb + 2)) { PHASE_WS
            for (int rp_ = 0; rp_ < REP_SEL; ++rp_) { const int bb = F.vcu >> 5, i = F.vcu & 31;
              bf16x8 sqf[8]; u32x4 sww;
              if (F.G == 256) { dsa_load_q(P, bb, i, F.lane, sqf, sww);
                  dsa_select_unit(F, P, maskT, bb, i, 63 - i, sqf, sww); dsa_select_unit(F, P, maskT, bb, 63 - i, 64 + i, sqf, sww); dsa_select_unit(F, P, maskT, bb, 64 + i, 127 - i, sqf, sww); dsa_select_unit(F, P, maskT, bb, 127 - i, -1, sqf, sww); }
              else for (int u = F.vcu; u < 1024; u += F.G) { dsa_load_q(P, u >> 7, u & 127, F.lane, sqf, sww); dsa_select_unit(F, P, maskT, u >> 7, u & 127, -1, sqf, sww); } }
            for (int rp_ = 0; rp_ < REP_DIL; ++rp_) for (int u = F.gw; u < 3 * 4096; u += 2 * F.NGW) dil_attn_pair(F, P, DO, DL, u, u + F.NGW);
            phase_requant(F, we + WE_GU / 2, (float*)(ws + WS_SB), (signed char*)(ws + WS_Q8D), 7168);
            phase_cvt<true>(F, lp, 0, CO_R0, true);
        }
        SEAM(pb + 2);
        if (IN(pb + 3)) { PHASE_WS
            CvtRider rd{CO_R0 + F.gw, CO_NIT, lp};
            for (int rp_ = 0; rp_ < REP_DSA; ++rp_) for (int u = F.vcu; u < 256; u += F.G) for (int rep = 0; rep < 2; ++rep) {
                const int bn = u >> 4, i = u & 15, qb = rep ? 31 - i : i, b = bn >> 1, n = bn & 1;
                const bf16_t* Pb = P + (size_t)b * SEQ * EV_NP; const int tq = 64 * qb + 32 * (F.wave & 1) + (F.lane & 31);
                block_attn_unit<1, 1>(F, rd, P, Pb + C_KA + n * 64, nullptr, Pb + C_VA + n * 64, maskT + (size_t)b * 64 * SEQ, MIX + (size_t)(b * SEQ + tq) * DM + (n * 4 + (F.wave >> 1)) * 64, b, n, qb); }
            for (; rd.it < rd.end; rd.it += F.NGW) { const CvtDesc d = cvt_odd_desc(F, lp, rd.it); f32x4 v[8]; cvt_load(d, F.lane, v); cvt_store(d, F.lane, v); }
            phase_dil_merge(F, DO, DL, MIX);
        }
        SEAM(pb + 3);
        if (IN(pb + 4)) { PHASE_WS
            pg8::Gemm g{MIX, we + WE_OUT / 2, DM, DM, 0, DM, nullptr}; pg8::StaticOrder S; S.init(MTOK, DM, F.G, (int)blockIdx.x);
            if constexpr (lp == 0) { pg8::EpiRes<true> E{X, F.gin(0)}; pg8::gemm_phase<pg8::EpiRes<true>, pg8::StaticOrder, true>(F.lds, g, S, E); }
            else { pg8::EpiRes<false> E{X, X}; pg8::gemm_phase<pg8::EpiRes<false>, pg8::StaticOrder, true>(F.lds, g, S, E); }
        }
        SEAM(pb + 4);
        if (IN(pb + 5)) { PHASE_WS phase_norm8(F, X, F.gin(4) + lp * DM, (signed char*)H, (float*)(ws + WS_MISC + MISC_RT + RT_SA));
            phase_requant(F, wo + WO_IN / 2, (float*)(ws + WS_SB + 288 * 1024), (signed char*)(ws + WS_Q8O), OD_NP); }
        SEAM(pb + 5);
        if (IN(pb + 6)) { PHASE_WS
            pg8::Gemm g{H, (const bf16_t*)(ws + WS_Q8D), DM / 2, DM / 2, 0, DM / 2, nullptr}; pg8::StaticOrder S; S.init(MTOK, 2 * DFF, F.G, (int)blockIdx.x);
            pg8::EpiSwiGLU8 E{ACT, (const float*)(ws + WS_MISC + MISC_RT + RT_SA), (const float*)(ws + WS_SB), 0};
            pg8::gemm_phase<pg8::EpiSwiGLU8, pg8::StaticOrder, true, false, true>(F.lds, g, S, E);
        }
        SEAM(pb + 6);
        if (IN(pb + 7)) { PHASE_WS
            pg8::Gemm g{ACT, we + WE_DN / 2, DFF, DFF, 0, DFF, nullptr}; pg8::StaticOrder S; S.init(MTOK, DM, F.G, (int)blockIdx.x);
            pg8::EpiRes<false> E{X, X};
            pg8::gemm_phase<pg8::EpiRes<false>, pg8::StaticOrder, true>(F.lds, g, S, E);
        }
        SEAM(pb + 7);
        if (IN(pb + 8)) { PHASE_WS phase_norm8(F, X, F.gin(8) + lp * DM, (signed char*)H, (float*)(ws + WS_MISC + MISC_RT + RT_SA)); }
        SEAM(pb + 8);
        if (IN(pb + 9)) { PHASE_WS
            pg8::Gemm g{H, (const bf16_t*)(ws + WS_Q8O), DM / 2, DM / 2, 0, DM / 2, nullptr}; pg8::StaticOrder S; S.init(MTOK, OD_NP, F.G, (int)blockIdx.x);
            pg8::EpiBf16Q<2> E{P2, OD_NP, rope, (const float*)(ws + WS_MISC + MISC_RT + RT_SA), (const float*)(ws + WS_SB + 288 * 1024)};
            pg8::gemm_phase<pg8::EpiBf16Q<2>, pg8::StaticOrder, true, false, true>(F.lds, g, S, E);
        }
        SEAM(pb + 9);
        if (IN(pb + 10)) { PHASE_WS
            phase_mla_norm(F, lp, P2, CQN, CKVN);
            for (int rp_ = 0; rp_ < REP_RG1; ++rp_) for (int u = F.gw; u < 4096; u += F.NGW) rg_unit<false>(F, lp, u >> 9, (u >> 3) & 63, u & 7, P2, wo + WO_RG / 2, agg, MIX);
            phase_requant(F, wo + WO_MGU / 2, (float*)(ws + WS_SB + 32 * 1024), (signed char*)(ws + WS_Q8M), NEXP * 7168);
            if (lp == 0) phase_cvt<false>(F, 1, 0, CE_NIT, true);
        }
        SEAM(pb + 10);
        if (IN(pb + 11)) { PHASE_WS
            if ((int)blockIdx.x >= F.G - 8) phase_rg_carry(F, agg, agg + 1024 * 1024 * 3 / 4, (int)blockIdx.x - (F.G - 8));
            { pg8::Gemm g{CQN, wo + WO_UQ / 2, 256, 256, 0, 256, nullptr}; pg8::StaticOrder S; S.init(MTOK, 768, F.G, (int)blockIdx.x);
              pg8::EpiBf16<3> E{Q2, 768, rope};
              pg8::gemm_phase<pg8::EpiBf16<3>, pg8::StaticOrder, true>(F.lds, g, S, E); }
            { pg8::Gemm g{CKVN, wo + WO_UKV / 2, 256, 256, 0, 256, nullptr}; pg8::StaticOrder S; S.init(MTOK, 1024, F.G, (int)blockIdx.x);
              pg8::EpiBf16<0> E{KV2, 1024, rope};
              pg8::gemm_phase<pg8::EpiBf16<0>, pg8::StaticOrder, true>(F.lds, g, S, E); }
        }
        SEAM(pb + 11);
        if (IN(pb + 12)) { PHASE_WS
            CvtRider rd{0, 0, 0};
            for (int rp_ = 0; rp_ < REP_MLA; ++rp_) for (int u = F.vcu; u < 256; u += F.G) for (int rep = 0; rep < 2; ++rep) {
                const int bh = u >> 2, i = u & 3, qb = rep ? 7 - i : i, b = bh >> 3, h = bh & 7;
                const bf16_t* kvb = KV2 + (size_t)b * SEQ * 1024 + h * 128; const int tq = 256 * qb + 32 * F.wave + (F.lane & 31);
                block_attn_unit<0, 0>(F, rd, Q2, kvb, P2 + (size_t)b * SEQ * OD_NP + C_KR, kvb + 64, nullptr, MIX + (size_t)(b * SEQ + tq) * DM + h * 64, b, h, qb); }
            for (int rp_ = 0; rp_ < REP_RG2; ++rp_) for (int u = F.gw; u < 4096; u += F.NGW) rg_unit<true>(F, lp, u >> 9, (u >> 3) & 63, u & 7, P2, wo + WO_RG / 2, agg, MIX);
            if (lp == 0) phase_requant(F, we + WE_IN / 2, (float*)(ws + WS_SB + 300 * 1024), (signed char*)(ws + WS_Q8E), EV_NP);
        }
        SEAM(pb + 12);
        if (IN(pb + 13)) { PHASE_WS
            pg8::Gemm g{MIX, wo + WO_OUT / 2, DM, DM, 0, DM, nullptr}; pg8::StaticOrder S; S.init(MTOK, DM, F.G, (int)blockIdx.x);
            pg8::EpiRes<false> E{X, X};
            pg8::gemm_phase<pg8::EpiRes<false>, pg8::StaticOrder, true>(F.lds, g, S, E);
        }
        SEAM(pb + 13);
        if (IN(pb + 14)) { PHASE_WS phase_norm_route(F, lp, F.gin(22) + lp * DM, H); }
        SEAM(pb + 14);
        if (IN(pb + 15)) { PHASE_WS phase_moe_scatter(F, lp); }
        SEAM(pb + 15);
        if (IN(pb + 16)) { PHASE_WS
            pg8::MoeOrder S; moe_tiles(F, lp, S.ts); S.nN = 2 * DFF / 256; S.nwg = S.ts[8] * S.nN; S.G = F.G; S.c = (int)blockIdx.x;
            const int* rtk = (const int*)(ws + WS_MISC + MISC_RT + 800 * 1024);
            pg8::Gemm g{H, (const bf16_t*)(ws + WS_Q8M), DM / 2, DM / 2, (size_t)2 * DFF * DM / 2, DM / 2, rtk};
            pg8::EpiSwiGLU8 E{ACT, (const float*)(ws + WS_MISC + MISC_RT + RT_SAG), (const float*)(ws + WS_SB + 32 * 1024), 7168};
            pg8::gemm_phase<pg8::EpiSwiGLU8, pg8::MoeOrder, true, true, true>(F.lds, g, S, E);
        }
        SEAM(pb + 16);
        if (IN(pb + 17)) { PHASE_WS
            { pg8::MoeOrder S; moe_tiles(F, lp, S.ts); const int T = S.ts[8]; (void)T; S.ts[8] = 128; S.nN = DM / 256; S.nwg = 128 * S.nN; S.G = F.G; S.c = (int)blockIdx.x;
              pg8::Gemm g{ACT, wo + WO_MDN / 2, DFF, DFF, (size_t)DM * DFF, DFF, nullptr};
              pg8::EpiBf16<0> E{(bf16_t*)Y, DM, rope};
              pg8::gemm_phase<pg8::EpiBf16<0>, pg8::MoeOrder, true>(F.lds, g, S, E); }
            { pg8::SplitOrder S; moe_tiles(F, lp, S.ts); S.nitems = (S.ts[8] - 128) * 4 * 7; S.c = (int)blockIdx.x; const int sl = S.c % 7;
              pg8::Gemm g{ACT + sl * 512, wo + WO_MDN / 2 + sl * 512, DFF, 512, (size_t)DM * DFF, DFF, nullptr};
              pg8::EpiF32 E{(float*)(ws + WS_PY + PY_XR) + (size_t)sl * 2048 * DM, nullptr, DM, 128 * 256};
              pg8::gemm_phase<pg8::EpiF32, pg8::SplitOrder, false>(F.lds, g, S, E); }
        }
        SEAM(pb + 17);
    }

__global__ void __launch_bounds__(512, 2) fwd(Args args) {
    extern __shared__ __attribute__((aligned(16))) unsigned char lds_raw[];
    Frame F;
    F.lds = (LAS unsigned char*)lds_raw; F.ws = args.ws; F.in = args.in;
    F.tid = threadIdx.x; F.lane = F.tid & 63; F.wave = __builtin_amdgcn_readfirstlane(F.tid >> 6);
    F.G = gridDim.x; { const int bx = blockIdx.x; F.vcu = (F.G % 8 == 0) ? (bx % 8) * (F.G / 8) + bx / 8 : bx; }
    F.gw = F.vcu * 8 + F.wave; F.NGW = F.G * 8;
    { volatile LAS unsigned* MISC = (volatile LAS unsigned*)(F.lds + LDS_MISC_OFF);
      for (int u = F.tid; u < (LDS_BYTES - LDS_MISC_OFF) / 4; u += 512) MISC[u] = 0u;
      __syncthreads();
      if (args.ph_hi - args.ph_lo > 1) (void)xcd_barrier_post((unsigned*)(args.ws + WS_CTL) + CW_BAR, MISC + 8); }
    if (PROBE_MASK != 0ull && blockIdx.x == 0 && threadIdx.x == 0) { volatile LAS unsigned long long* pt = (volatile LAS unsigned long long*)(F.lds + LDS_MISC_OFF + 64); pt[0] = wall_clock64(); pt[1] = 0ull; }
    pair_body<0>(F, args);
    pair_body<1>(F, args);
    if (IN(2 * NPH_PAIR)) { PHASE_WS GAS float* out_ = (GAS float*)args.out; asm volatile("" : "+s"(out_)); phase_norm<2>(F, nullptr, F.gin(27), nullptr, (float*)out_); }
    if (PROBE_MASK != 0ull && blockIdx.x == 0 && threadIdx.x == 0) { volatile LAS unsigned long long* pt = (volatile LAS unsigned long long*)(F.lds + LDS_MISC_OFF + 64); const unsigned long long t0 = wall_clock64(), w = pt[1] * PROBE_MUL; while (wall_clock64() - t0 < w) __builtin_amdgcn_s_sleep(8); }
#undef IN
#undef SEAM
}

extern "C" void kernel_launch(void* const* d_in, const int* in_sizes, int n_in, void* d_out, int out_size, void* d_ws, size_t ws_size, hipStream_t stream) {
    static int grid = 0;
    if (grid == 0) {
        if (n_in != 28 || out_size != MTOK * DM || ws_size < WS_END) { fprintf(stderr, "kernel_launch: unexpected shapes (n_in %d, out %d, ws %zu)\n", n_in, out_size, ws_size); grid = -1; return; }
        int dev = 0, cus = 0, per_cu = 0;
        if (hipGetDevice(&dev) != hipSuccess || hipDeviceGetAttribute(&cus, hipDeviceAttributeMultiprocessorCount, dev) != hipSuccess) { grid = -1; return; }
        if (hipFuncSetAttribute((const void*)fwd, hipFuncAttributeMaxDynamicSharedMemorySize, LDS_BYTES) != hipSuccess) { fprintf(stderr, "kernel_launch: hipFuncSetAttribute failed\n"); grid = -1; return; }
        if (hipOccupancyMaxActiveBlocksPerMultiprocessor(&per_cu, (const void*)fwd, 512, LDS_BYTES) != hipSuccess || per_cu < 1) fprintf(stderr, "kernel_launch: occupancy query reports %d\n", per_cu);
        (void)hipGetLastError();
        grid = cus;
    }
    if (grid < 0) return;
    (void)hipMemsetAsync((char*)d_ws + WS_CTL, 0, (size_t)(CW_BAR + XCD_BAR_WORDS) * 4, stream);
    Args a{};
    for (int i = 0; i < 28; ++i) a.in[i] = (const float*)d_in[i];
    a.out = (float*)d_out; a.ws = (unsigned char*)d_ws;
#if MK_MULTI
#ifndef MK_PHMAX
#define MK_PHMAX NPH
#endif
    for (int p = 0; p < MK_PHMAX; ++p) { a.ph_lo = p; a.ph_hi = p + 1; hipLaunchKernelGGL(fwd, dim3(grid), dim3(512), LDS_BYTES, stream, a); }
#else
    a.ph_lo = 0; a.ph_hi = NPH; hipLaunchKernelGGL(fwd, dim3(grid), dim3(512), LDS_BYTES, stream, a);
#endif
}
```
